# Optimizing an MI355X kernel written in HIP

```python
import numpy as np
import jax
import jax.numpy as jnp
from jax import lax

D_MODEL = 1024
BATCH = 8
SEQ = 2048
DEPTH = 1

NSA_HEADS = 8
NSA_KV_GROUPS = 2
NSA_HEAD_DIM = 64
NSA_REP = NSA_HEADS // NSA_KV_GROUPS
NSA_BRANCHES = 3
CMP_STRIDE = 16
CMP_BLOCK = 2 * CMP_STRIDE
CMP_HIDDEN = 2 * NSA_HEAD_DIM
SLC_BLOCK = 64
SLC_TOPK = 8
WINDOW = 512
Q_BLOCK = 128
RET_HEADS = 4
RET_HEAD_DIM = 128
RET_CHUNK = 128
N_BRANCH = 2
BRANCH_WIDTH = NSA_HEADS * NSA_HEAD_DIM
D_FF = -(-8 * D_MODEL // (3 * 256)) * 256
EPS = 1e-6
NEG_INF = -1e9
FORCE_BONUS = 1e4
Q_W = NSA_HEADS * NSA_HEAD_DIM
KV_W = NSA_BRANCHES * 2 * NSA_KV_GROUPS * NSA_HEAD_DIM
NSA_GATE_W = NSA_HEADS * NSA_BRANCHES
RET_W = 4 * RET_HEADS * RET_HEAD_DIM
MERGE_W = N_BRANCH * D_MODEL
N_IN = Q_W + KV_W + NSA_GATE_W + RET_W + MERGE_W

kernel_name = 'hybrid_nsa_retention_block'


def rms_norm(x, g):
    xf = x.astype(jnp.float32)
    y = xf * lax.rsqrt(jnp.mean(xf * xf, axis=-1, keepdims=True) + EPS)
    return (y * g.astype(jnp.float32)).astype(x.dtype)


def alibi_slopes(n):
    return jnp.asarray(2.0 ** (-8.0 * (np.arange(n) + 1) / n), dtype=jnp.float32)


def masked_softmax(s, mask):
    s = jnp.where(mask, s, NEG_INF)
    p = jax.nn.softmax(s, axis=-1)
    return jnp.where(mask, p, 0.0)


def compress_blocks(t, pe, w1, w2):
    b, s, g, d = t.shape
    chunks = t.reshape(b, s // CMP_STRIDE, CMP_STRIDE, g, d)
    blocks = jnp.concatenate([chunks[:, :-1], chunks[:, 1:]], axis=2)
    blocks = blocks + pe[None, None, :, None, :]
    hid = jax.nn.gelu(jnp.einsum('bnlgd,ldf->bngf', blocks, w1))
    return jnp.einsum('bngf,fd->bngd', hid, w2)


def nsa_attention(q, kv, gate_logits, q_g, k_g, cmp_pe, cmp_w1, cmp_w2):
    b, s, h, d = q.shape
    G, R = NSA_KV_GROUPS, NSA_REP
    f32 = jnp.float32
    scale = d ** -0.5
    slopes = alibi_slopes(h).reshape(G, R)
    qg = rms_norm(q, q_g).reshape(b, s, G, R, d)
    k_cmp, v_cmp = kv[:, :, 0, 0], kv[:, :, 0, 1]
    k_slc, v_slc = kv[:, :, 1, 0], kv[:, :, 1, 1]
    k_win, v_win = kv[:, :, 2, 0], kv[:, :, 2, 1]
    t_pos = jnp.arange(s)

    kc = rms_norm(compress_blocks(k_cmp, cmp_pe[0], cmp_w1[0], cmp_w2[0]), k_g[0])
    vc = compress_blocks(v_cmp, cmp_pe[1], cmp_w1[1], cmp_w2[1])
    n_cmp = kc.shape[1]
    c_end = jnp.arange(n_cmp) * CMP_STRIDE + CMP_BLOCK - 1
    c_dist = (t_pos[:, None] - c_end[None, :]).astype(f32)
    sc = jnp.einsum('btgrd,bngd->bgrtn', qg, kc).astype(f32) * scale - slopes[:, :, None, None] * c_dist
    p_cmp = masked_softmax(sc, c_dist >= 0)
    o_cmp = jnp.einsum('bgrtn,bngd->btgrd', p_cmp.astype(vc.dtype), vc)

    n_slc = s // SLC_BLOCK
    cs = np.arange(n_cmp) * CMP_STRIDE
    ss = np.arange(n_slc) * SLC_BLOCK
    overlap = (cs[:, None] <= ss[None, :] + SLC_BLOCK - 1) & (cs[:, None] + CMP_BLOCK - 1 >= ss[None, :])
    overlap = jnp.asarray(overlap, f32)
    imp = jnp.einsum('bgtn,nj->bgtj', p_cmp.sum(axis=2), overlap)
    j = jnp.arange(n_slc)[None, :]
    cur = (t_pos // SLC_BLOCK)[:, None]
    forced = (j == 0) | (j == cur) | (j == cur - 1)
    blk_valid = j * SLC_BLOCK <= t_pos[:, None]
    imp = jnp.where(blk_valid, imp + jnp.where(forced, FORCE_BONUS, 0.0), NEG_INF)
    n_top = min(SLC_TOPK, n_slc)
    _, sel_idx = lax.top_k(imp, n_top)
    n_sel = n_top * SLC_BLOCK

    ks_blk = rms_norm(k_slc, k_g[1]).reshape(b, n_slc, SLC_BLOCK, G, d).transpose(0, 3, 1, 2, 4)
    vs_blk = v_slc.reshape(b, n_slc, SLC_BLOCK, G, d).transpose(0, 3, 1, 2, 4)
    pad = ((0, 0), (WINDOW, 0), (0, 0), (0, 0))
    kw_pad = jnp.pad(rms_norm(k_win, k_g[2]), pad)
    vw_pad = jnp.pad(v_win, pad)
    gather_blocks = jax.vmap(jax.vmap(lambda blk, idx: blk[idx]))
    offs = jnp.arange(SLC_BLOCK)

    def query_block(c):
        s0 = c * Q_BLOCK
        tq = s0 + jnp.arange(Q_BLOCK)
        qc = lax.dynamic_slice_in_dim(qg, s0, Q_BLOCK, axis=1)
        idx = lax.dynamic_slice_in_dim(sel_idx, s0, Q_BLOCK, axis=2)
        ksel = gather_blocks(ks_blk, idx).reshape(b, G, Q_BLOCK, n_sel, d)
        vsel = gather_blocks(vs_blk, idx).reshape(b, G, Q_BLOCK, n_sel, d)
        kpos = (idx[..., None] * SLC_BLOCK + offs).reshape(b, G, Q_BLOCK, n_sel)
        sdist = (tq[None, None, :, None] - kpos).astype(f32)
        s_sel = (jnp.einsum('btgrd,bgtld->bgrtl', qc, ksel).astype(f32) * scale
                 - slopes[None, :, :, None, None] * sdist[:, :, None])
        p = masked_softmax(s_sel, (sdist >= 0)[:, :, None])
        o_slc = jnp.einsum('bgrtl,bgtld->btgrd', p.astype(vsel.dtype), vsel)
        kwin = lax.dynamic_slice_in_dim(kw_pad, s0, Q_BLOCK + WINDOW, axis=1)
        vwin = lax.dynamic_slice_in_dim(vw_pad, s0, Q_BLOCK + WINDOW, axis=1)
        wpos = s0 - WINDOW + jnp.arange(Q_BLOCK + WINDOW)
        wdist = tq[:, None] - wpos[None, :]
        wvalid = (wdist >= 0) & (wdist < WINDOW) & (wpos[None, :] >= 0)
        s_win = (jnp.einsum('btgrd,blgd->bgrtl', qc, kwin).astype(f32) * scale
                 - slopes[:, :, None, None] * wdist.astype(f32))
        p = masked_softmax(s_win, wvalid)
        o_win = jnp.einsum('bgrtl,blgd->btgrd', p.astype(vwin.dtype), vwin)
        return o_slc, o_win

    o_slc, o_win = lax.map(query_block, jnp.arange(s // Q_BLOCK))
    o_slc = jnp.moveaxis(o_slc, 0, 1).reshape(b, s, G, R, d)
    o_win = jnp.moveaxis(o_win, 0, 1).reshape(b, s, G, R, d)
    gate = jax.nn.sigmoid(gate_logits.astype(f32)).reshape(b, s, G, R, NSA_BRANCHES, 1)
    o = gate[..., 0, :] * o_cmp + gate[..., 1, :] * o_slc + gate[..., 2, :] * o_win
    return o.reshape(b, s, h * d).astype(q.dtype)


def retention(q, k, v, g, gn_g):
    b, s, h, d = q.shape
    f32 = jnp.float32
    C = RET_CHUNK
    n_ch = s // C
    log_gamma = jnp.asarray(np.log(1.0 - 2.0 ** (-5.0 - np.arange(h))), f32)
    i = jnp.arange(C, dtype=f32)
    rel = i[:, None] - i[None, :]
    inner_decay = jnp.where(rel >= 0, jnp.exp(jnp.maximum(rel, 0.0)[None] * log_gamma[:, None, None]), 0.0)
    q_decay = jnp.exp((i[:, None] + 1.0) * log_gamma[None, :])
    k_decay = jnp.exp((C - 1.0 - i[:, None]) * log_gamma[None, :])
    chunk_decay = jnp.exp(C * log_gamma)

    def to_chunks(t):
        return t.astype(f32).reshape(b, n_ch, C, h, t.shape[-1]).swapaxes(0, 1)

    qs, ks, vs = to_chunks(q), to_chunks(k * d ** -0.5), to_chunks(v)

    def step(state, inp):
        qc, kc, vc = inp
        att = jnp.einsum('bihd,bjhd->bhij', qc, kc) * inner_decay[None]
        o = (jnp.einsum('bhij,bjhe->bihe', att, vc)
             + jnp.einsum('bihd,bhde->bihe', qc * q_decay[None, :, :, None], state))
        state = (state * chunk_decay[None, :, None, None]
                 + jnp.einsum('bjhd,bjhe->bhde', kc * k_decay[None, :, :, None], vc))
        return state, o

    state0 = jnp.zeros((b, h, d, v.shape[-1]), f32)
    _, o = lax.scan(step, state0, (qs, ks, vs))
    o = o.swapaxes(0, 1).reshape(b, s, h, v.shape[-1])
    mu = jnp.mean(o, axis=-1, keepdims=True)
    var = jnp.mean(jnp.square(o - mu), axis=-1, keepdims=True)
    on = (o - mu) * lax.rsqrt(var + EPS) * gn_g.astype(f32)
    out = jax.nn.silu(g.astype(f32)).reshape(b, s, -1) * on.reshape(b, s, -1)
    return out.astype(q.dtype)


def setup_inputs(seed: int = 0) -> dict:
    key = jax.random.key(seed)
    ks = jax.random.split(key, 16)
    f32 = jnp.float32

    def nrm(k, shape, scale):
        return jax.random.normal(k, shape, f32) * scale

    def gain(k, shape):
        return 1.0 + 0.01 * jax.random.normal(k, shape, f32)

    L, dh = DEPTH, NSA_HEAD_DIM
    return {
        'x': jax.random.normal(ks[0], (BATCH, SEQ, D_MODEL), f32),
        'norm1_g': gain(ks[1], (L, D_MODEL)),
        'w_in': nrm(ks[2], (L, D_MODEL, N_IN), D_MODEL ** -0.5),
        'nsa_q_norm': gain(ks[3], (L, dh)),
        'nsa_k_norm': gain(ks[4], (L, NSA_BRANCHES, dh)),
        'cmp_pe': nrm(ks[5], (L, 2, CMP_BLOCK, dh), 0.1),
        'cmp_w1': nrm(ks[6], (L, 2, CMP_BLOCK, dh, CMP_HIDDEN), (CMP_BLOCK * dh) ** -0.5),
        'cmp_w2': nrm(ks[7], (L, 2, CMP_HIDDEN, dh), CMP_HIDDEN ** -0.5),
        'ret_gn_g': gain(ks[8], (L, RET_HEADS, RET_HEAD_DIM)),
        'w_branch': nrm(ks[9], (L, N_BRANCH, BRANCH_WIDTH, D_MODEL), BRANCH_WIDTH ** -0.5),
        'w_out': nrm(ks[10], (L, D_MODEL, D_MODEL), D_MODEL ** -0.5),
        'norm2_g': gain(ks[11], (L, D_MODEL)),
        'ffn_w_gate': nrm(ks[12], (L, D_MODEL, D_FF), D_MODEL ** -0.5),
        'ffn_w_up': nrm(ks[13], (L, D_MODEL, D_FF), D_MODEL ** -0.5),
        'ffn_w_down': nrm(ks[14], (L, D_FF, D_MODEL), D_FF ** -0.5),
    }


def reference(x, norm1_g, w_in, nsa_q_norm, nsa_k_norm, cmp_pe, cmp_w1, cmp_w2, ret_gn_g,
              w_branch, w_out, norm2_g, ffn_w_gate, ffn_w_up, ffn_w_down):
    b, s, _ = x.shape
    splits = [Q_W, Q_W + KV_W, Q_W + KV_W + NSA_GATE_W, Q_W + KV_W + NSA_GATE_W + RET_W]
    for l in range(DEPTH):
        h = rms_norm(x, norm1_g[l])
        z = jnp.einsum('bsd,dn->bsn', h, w_in[l])
        zq, zkv, zg, zr, zm = jnp.split(z, splits, axis=-1)
        y_nsa = nsa_attention(
            zq.reshape(b, s, NSA_HEADS, NSA_HEAD_DIM),
            zkv.reshape(b, s, NSA_BRANCHES, 2, NSA_KV_GROUPS, NSA_HEAD_DIM),
            zg.reshape(b, s, NSA_HEADS, NSA_BRANCHES),
            nsa_q_norm[l], nsa_k_norm[l], cmp_pe[l], cmp_w1[l], cmp_w2[l])
        zr = zr.reshape(b, s, 4, RET_HEADS, RET_HEAD_DIM)
        y_ret = retention(zr[:, :, 0], zr[:, :, 1], zr[:, :, 2], zr[:, :, 3], ret_gn_g[l])
        u = jnp.einsum('nbsc,ncd->bsnd', jnp.stack([y_nsa, y_ret]), w_branch[l])
        gates = jax.nn.sigmoid(zm.reshape(b, s, N_BRANCH, D_MODEL).astype(jnp.float32))
        mixed = jnp.sum(gates * u, axis=2).astype(x.dtype)
        x = x + jnp.einsum('bsd,de->bse', mixed, w_out[l])
        h = rms_norm(x, norm2_g[l])
        ff = jax.nn.silu(h @ ffn_w_gate[l]) * (h @ ffn_w_up[l])
        x = x + ff @ ffn_w_down[l]
    return x
```

```cpp
#include <hip/hip_runtime.h>
#include <hip/hip_cooperative_groups.h>
#include <cstdio>
#include <cstdint>
#include <cmath>
#ifndef PG8_WGM
#define PG8_WGM 8
#endif
namespace pg8 {
#define PG8_LAS __attribute__((address_space(3)))
typedef unsigned short bf16_t;
typedef short bf16x8 __attribute__((ext_vector_type(8)));
typedef float f32x4 __attribute__((ext_vector_type(4)));
typedef unsigned u32x4 __attribute__((ext_vector_type(4)));
constexpr int BM = 256, BK = 64, HALF = 128, HTB = HALF * BK * 2  , STAGE_BYTES = 8 * HTB, NXCD = 8, WGM = PG8_WGM;

__host__ __device__ __forceinline__ int lds_byte(int r, int c) { const int st = (r >> 4) * 2 + (c >> 5), rr = r & 15, cc = c & 31, ob = rr * 64 + cc * 2; return st * 1024 + (ob ^ (((ob >> 9) & 1) << 5)); }
__host__ __device__ __forceinline__ void stage_rc(int b, int& R, int& C) { const int st = b / 1024, sb = b % 1024, swz = sb ^ (((sb >> 9) & 1) << 5); R = (st >> 1) * 16 + swz / 64; C = (st & 1) * 32 + (swz % 64) / 2; }
__host__ __device__ __forceinline__ int perm32(int rho) { const int n = rho >> 4, i = rho & 15; return 8 * (i >> 2) + 4 * n + (i & 3); }

struct Unit { int pm, pn; };
struct Gemm { const bf16_t* A; const bf16_t* Bt; int M, N, K; int wid; };

struct StaticOrder {
    int nM, nN, nwg, G, c;
    __host__ __device__ __forceinline__ void init(int M, int N, int G_, int c_) { nM = M / BM; nN = N / BM; nwg = nM * nN; G = G_; c = c_; }
    __host__ __device__ __forceinline__ bool next(int i, Unit& u) const {
        const long L = (long)i * G + c; if (L >= nwg) return false;
        int wgid = (int)L; { const int q = nwg / NXCD, r = nwg % NXCD, xcd = wgid % NXCD, off = wgid / NXCD; wgid = (xcd < r ? xcd * (q + 1) : r * (q + 1) + (xcd - r) * q) + off; }
        const int nig = WGM * nN, gid = wgid / nig, fm = gid * WGM, gsz = (nM - fm) < WGM ? (nM - fm) : WGM;
        u.pm = fm + ((wgid % nig) % gsz); u.pn = (wgid % nig) / gsz; return true;
    }
    __device__ __forceinline__ void a_ready(const Unit&) const {}
    __device__ __forceinline__ void done(const Unit&) const {}
};

__device__ __forceinline__ unsigned cvt_pk_bf16(float lo, float hi) { unsigned r; asm volatile("v_cvt_pk_bf16_f32 %0, %1, %2" : "=v"(r) : "v"(lo), "v"(hi)); return r; }
template <class Epi, class Sched, bool ALIGN_EPI = false, bool SP2 = false>
__device__ __forceinline__ void gemm_phase(PG8_LAS unsigned char* lds, const Gemm g, const Sched& S, const Epi& E) {
    const int wid = g.wid, lane = (int)__builtin_amdgcn_mbcnt_hi(~0u, __builtin_amdgcn_mbcnt_lo(~0u, (unsigned)g.wid * 0u)), tid = wid * 64 + lane, wr = wid >> 2, wc = wid & 3, fr = lane & 15, fq = lane >> 4;
    const int K = g.K, nt = K / BK;
    unsigned voffA[2], voffB[2];
#pragma unroll
    for (int i = 0; i < 2; ++i) { int R, C; stage_rc(tid * 16 + i * 8192, R, C); const int Rb = Epi::PERM ? ((R & ~31) + perm32(R & 31)) : R;
        voffA[i] = (unsigned)(R * K + C) * 2u; voffB[i] = (unsigned)(Rb * K + C) * 2u; }
    const size_t kstep = (size_t)(BK * 2);
    const size_t hstep = (size_t)HALF * K * 2;
    const size_t tstep = 2 * hstep;
    const unsigned ldsw = (unsigned)wid * 1024u;
    const int aoff = lds_byte(wr * 64 + fr, fq * 8), boff = lds_byte(wc * 32 + fr, fq * 8);
#define PG8_SA(b, h) (((b) * 2 + (h)) * HTB)
#define PG8_SB(b, h) ((4 + (b) * 2 + (h)) * HTB)
#define PG8_STAGE(bufoff, gbase, voff) do { _Pragma("unroll") for (int _i = 0; _i < 2; ++_i) \
        __builtin_amdgcn_global_load_lds((const unsigned*)((const char*)(gbase) + (voff)[_i]), (PG8_LAS unsigned*)(lds + (bufoff) + ldsw + _i * 8192), 16, 0, 0); } while (0)
#define PG8_LDA(dst, b, h) do { _Pragma("unroll") for (int m = 0; m < 4; ++m) _Pragma("unroll") for (int k = 0; k < 2; ++k) dst[m][k] = *(const PG8_LAS bf16x8*)(lds + PG8_SA(b, h) + aoff + m * 2048 + k * 1024); } while (0)
#define PG8_LDB(dst, b, h) do { _Pragma("unroll") for (int n = 0; n < 2; ++n) _Pragma("unroll") for (int k = 0; k < 2; ++k) dst[n][k] = *(const PG8_LAS bf16x8*)(lds + PG8_SB(b, h) + boff + n * 2048 + k * 1024); } while (0)
#define PG8_MMA(ai, bj, At, Bt) do { __builtin_amdgcn_s_setprio(1); _Pragma("unroll") for (int m = 0; m < 4; ++m) _Pragma("unroll") for (int n = 0; n < 2; ++n) _Pragma("unroll") for (int k = 0; k < 2; ++k) \
        acc[ai][bj][m][n] = __builtin_amdgcn_mfma_f32_16x16x32_bf16(Bt[n][k], At[m][k], acc[ai][bj][m][n], 0, 0, 0); __builtin_amdgcn_s_setprio(0); } while (0)
#define PG8_WAIT_V(n) asm volatile("s_waitcnt vmcnt(" #n ")" ::: "memory")
#define PG8_WAIT_L(n) asm volatile("s_waitcnt lgkmcnt(" #n ")" ::: "memory")
#define PG8_BAR __builtin_amdgcn_s_barrier()
#define PG8_SCHED __builtin_amdgcn_sched_barrier(0)
    Unit cur, nxt; int ui = 0;
    if (!S.next(0, cur)) return;
    f32x4 acc[2][2][4][2];
#pragma unroll
    for (int a = 0; a < 2; ++a)
#pragma unroll
        for (int b = 0; b < 2; ++b)
#pragma unroll
            for (int m = 0; m < 4; ++m)
#pragma unroll
                for (int n = 0; n < 2; ++n) acc[a][b][m][n] = (f32x4){0.f, 0.f, 0.f, 0.f};
    bf16x8 At[4][2], B0[2][2], B1[2][2];
    const char* cA = (const char*)g.A + (size_t)cur.pm * tstep; const char* cB = (const char*)g.Bt + (size_t)cur.pn * tstep;
    S.a_ready(cur);
    if constexpr (SP2) {
        PG8_STAGE(PG8_SB(0, 0), cB, voffB); PG8_STAGE(PG8_SB(0, 1), cB + hstep, voffB); PG8_STAGE(PG8_SA(0, 0), cA, voffA); PG8_STAGE(PG8_SA(0, 1), cA + hstep, voffA);
        if (wr == 1) PG8_BAR;
        PG8_WAIT_V(2); PG8_BAR;
        PG8_STAGE(PG8_SB(1, 0), cB + kstep, voffB); PG8_STAGE(PG8_SA(1, 0), cA + kstep, voffA); PG8_STAGE(PG8_SB(1, 1), cB + hstep + kstep, voffB);
        PG8_WAIT_V(6); PG8_BAR;
    } else {
        PG8_STAGE(PG8_SB(0, 0), cB, voffB); PG8_STAGE(PG8_SA(0, 0), cA, voffA); PG8_STAGE(PG8_SB(0, 1), cB + hstep, voffB); PG8_STAGE(PG8_SA(0, 1), cA + hstep, voffA);
        if (wr == 1) PG8_BAR;
        PG8_WAIT_V(4); PG8_BAR;
        PG8_STAGE(PG8_SB(1, 0), cB + kstep, voffB); PG8_STAGE(PG8_SA(1, 0), cA + kstep, voffA); PG8_STAGE(PG8_SB(1, 1), cB + hstep + kstep, voffB);
        PG8_WAIT_V(6); PG8_BAR;
    }
    for (;;) {
        const bool has_next = S.next(ui + 1, nxt);
        const char* nA = has_next ? (const char*)g.A + (size_t)nxt.pm * tstep : cA; const char* nB = has_next ? (const char*)g.Bt + (size_t)nxt.pn * tstep : cB;
        for (int t = 0; t < nt; t += 2) {
            if constexpr (Epi::HAS_MID) { if (t == nt / 2) E.mid(acc, cur, wr, wc, fr, fq); }
            const bool last = (t == nt - 2);
            const char* a1 = cA + (size_t)(t + 1) * kstep;
            const char* a2 = last ? nA : cA + (size_t)(t + 2) * kstep; const char* b2 = last ? nB : cB + (size_t)(t + 2) * kstep;
            const char* a3 = a2 + kstep; const char* b3 = b2 + kstep;
            if (last && has_next) S.a_ready(nxt);
            if constexpr (SP2) {
            PG8_LDB(B0, 0, 0); PG8_LDB(B1, 0, 1); PG8_SCHED; PG8_LDA(At, 0, 0); PG8_STAGE(PG8_SA(1, 1), a1 + hstep, voffA);
            PG8_WAIT_V(8); PG8_WAIT_L(0); PG8_BAR; PG8_MMA(0, 0, At, B0); PG8_MMA(0, 1, At, B1); PG8_BAR; PG8_SCHED;
            PG8_LDA(At, 0, 1); PG8_STAGE(PG8_SB(0, 0), b2, voffB); PG8_STAGE(PG8_SB(0, 1), b2 + hstep, voffB); PG8_STAGE(PG8_SA(0, 0), a2, voffA);
            PG8_WAIT_V(8); PG8_WAIT_L(0); PG8_BAR; PG8_MMA(1, 0, At, B0); PG8_MMA(1, 1, At, B1); PG8_BAR; PG8_SCHED;
            PG8_LDB(B0, 1, 0); PG8_LDB(B1, 1, 1); PG8_SCHED; PG8_LDA(At, 1, 0); PG8_STAGE(PG8_SA(0, 1), a2 + hstep, voffA);
            PG8_WAIT_V(8); PG8_WAIT_L(0); PG8_BAR; PG8_MMA(0, 0, At, B0); PG8_MMA(0, 1, At, B1); PG8_BAR; PG8_SCHED;
            PG8_LDA(At, 1, 1); PG8_STAGE(PG8_SB(1, 0), b3, voffB); PG8_STAGE(PG8_SB(1, 1), b3 + hstep, voffB); PG8_STAGE(PG8_SA(1, 0), a3, voffA);
            PG8_WAIT_V(8); PG8_WAIT_L(0); PG8_BAR; PG8_MMA(1, 0, At, B0); PG8_MMA(1, 1, At, B1); PG8_BAR; PG8_SCHED;
            } else {
            PG8_LDB(B0, 0, 0); PG8_SCHED; PG8_LDA(At, 0, 0); PG8_STAGE(PG8_SA(1, 1), a1 + hstep, voffA);
            PG8_WAIT_L(8); PG8_BAR; PG8_WAIT_L(0); PG8_MMA(0, 0, At, B0); PG8_BAR; PG8_SCHED;
            PG8_LDB(B1, 0, 1); PG8_STAGE(PG8_SB(0, 0), b2, voffB);
            PG8_BAR; PG8_WAIT_L(0); PG8_MMA(0, 1, At, B1); PG8_BAR;
            PG8_LDA(At, 0, 1); PG8_STAGE(PG8_SA(0, 0), a2, voffA);
            PG8_BAR; PG8_WAIT_L(0); PG8_MMA(1, 0, At, B0); PG8_BAR; PG8_SCHED;
            PG8_STAGE(PG8_SB(0, 1), b2 + hstep, voffB);
            PG8_WAIT_V(6); PG8_BAR; PG8_MMA(1, 1, At, B1); PG8_BAR;
            PG8_LDB(B0, 1, 0); PG8_SCHED; PG8_LDA(At, 1, 0); PG8_STAGE(PG8_SA(0, 1), a2 + hstep, voffA);
            PG8_WAIT_L(8); PG8_BAR; PG8_WAIT_L(0); PG8_MMA(0, 0, At, B0); PG8_BAR; PG8_SCHED;
            PG8_LDB(B1, 1, 1); PG8_STAGE(PG8_SB(1, 0), b3, voffB);
            PG8_BAR; PG8_WAIT_L(0); PG8_MMA(0, 1, At, B1); PG8_BAR;
            PG8_LDA(At, 1, 1); PG8_STAGE(PG8_SA(1, 0), a3, voffA);
            PG8_BAR; PG8_WAIT_L(0); PG8_MMA(1, 0, At, B0); PG8_BAR; PG8_SCHED;
            PG8_STAGE(PG8_SB(1, 1), b3 + hstep, voffB);
            PG8_WAIT_V(6); PG8_BAR; PG8_MMA(1, 1, At, B1); PG8_BAR;
            }
        }
        if constexpr (ALIGN_EPI) { if (wr == 0) PG8_BAR; }
        if constexpr (!Epi::AFTER_DRAIN) { E(acc, cur, wr, wc, fr, fq); S.done(cur); }
        if (!has_next) break;
#pragma unroll
        for (int a = 0; a < 2; ++a)
#pragma unroll
            for (int b = 0; b < 2; ++b)
#pragma unroll
                for (int m = 0; m < 4; ++m)
#pragma unroll
                    for (int n = 0; n < 2; ++n) acc[a][b][m][n] = (f32x4){0.f, 0.f, 0.f, 0.f};
        cur = nxt; cA = nA; cB = nB; ++ui;
        if constexpr (ALIGN_EPI) { if (wr == 1) PG8_BAR; }
    }
    PG8_WAIT_V(0);
    if constexpr (!ALIGN_EPI) { if (wr == 0) PG8_BAR; }
    PG8_BAR;
    if constexpr (Epi::AFTER_DRAIN) { E.fused(acc, cur, wr, wc, fr, fq, lds, wid, lane); S.done(cur); }
#undef PG8_SA
#undef PG8_SB
#undef PG8_STAGE
#undef PG8_LDA
#undef PG8_LDB
#undef PG8_MMA
#undef PG8_WAIT_V
#undef PG8_WAIT_L
#undef PG8_BAR
#undef PG8_SCHED
}
}

namespace cg = cooperative_groups;
#ifndef MK_SPLIT
#define MK_SPLIT 0
#endif
#define DI __device__ __forceinline__
#define LAS __attribute__((address_space(3)))
typedef unsigned short bf16;
typedef short bf16x8 __attribute__((ext_vector_type(8)));
typedef float f32x4 __attribute__((ext_vector_type(4)));
typedef float f32x16 __attribute__((ext_vector_type(16)));
typedef unsigned u32x4 __attribute__((ext_vector_type(4)));
typedef unsigned u32x2 __attribute__((ext_vector_type(2)));
typedef float f32x2_t __attribute__((ext_vector_type(2)));
typedef __bf16 bf16x2_t __attribute__((ext_vector_type(2)));
#define LDS_WAIT() asm volatile("s_waitcnt lgkmcnt(0)" ::: "memory")
#define MFMA32(a, b, c) __builtin_amdgcn_mfma_f32_32x32x16_bf16((a), (b), (c), 0, 0, 0)

constexpr int BATCH = 8, SEQ = 2048, DM = 1024, M = BATCH * SEQ;
constexpr int NIN = 5400, NINP = 5632, DFF = 2816, NGU = 5632;
constexpr float EPS = 1e-6f, LOG2E = 1.4426950408889634f;
constexpr float NEGINF = -__builtin_huge_valf();

constexpr size_t MiB = 1u << 20;
constexpr size_t WS_BIASP = 0;
constexpr size_t WS_W2T = 64 * 1024;
constexpr size_t WS_BAR = 512 * 1024, BAR_BYTES = 16384;
constexpr size_t WS_SSQ = 1 * MiB;
constexpr size_t WS_WIN = 2 * MiB;
constexpr size_t WS_WGU = 13 * MiB;
constexpr size_t WS_WDN = 24 * MiB;
constexpr size_t WS_WB = 30 * MiB;
constexpr size_t WS_WO = 32 * MiB;
constexpr size_t WS_W1T = 34 * MiB;
constexpr size_t WS_KC = 35 * MiB;
constexpr size_t WS_VCT = 35 * MiB + 512 * 1024;
constexpr size_t WS_ZG = 36 * MiB;
constexpr size_t WS_RK = 37 * MiB, WS_RV = 53 * MiB;
constexpr size_t WS_X1B = 37 * MiB;
constexpr size_t WS_ZM = 69 * MiB;
constexpr size_t WS_ZQ = 133 * MiB;
constexpr size_t WS_ZKV = 181 * MiB;
constexpr size_t WS_HID = 69 * MiB;
constexpr size_t WS_RQ = 149 * MiB, WS_RG = 165 * MiB;
constexpr size_t WS_Y = 181 * MiB;
constexpr size_t WS_H = 205 * MiB;
constexpr size_t WS_KVT = 221 * MiB;
constexpr size_t WS_MIX = 133 * MiB;
constexpr size_t WS_KN = 237 * MiB;
constexpr size_t WS_VT = 245 * MiB;
constexpr size_t WS_END = 253 * MiB;
constexpr int LDS_BYTES = 147456;

struct Args {
    const float* x; const float* n1g; const float* win; const float* qg; const float* kg; const float* pe; const float* w1; const float* w2;
    const float* gng; const float* wb; const float* wo; const float* n2g; const float* wg; const float* wu; const float* wd;
    float* out; unsigned char* ws; int ph_lo, ph_hi, coop, pad;
};

DI float bf2f(unsigned short b) { return __uint_as_float((unsigned)b << 16); }
DI unsigned pk2(float lo, float hi) { f32x2_t v = {lo, hi}; bf16x2_t b = __builtin_convertvector(v, bf16x2_t); return __builtin_bit_cast(unsigned, b); }
DI unsigned short f2bf(float f) { return (unsigned short)(pk2(f, 0.f) & 0xffffu); }
DI float lo16(unsigned w) { return __uint_as_float(w << 16); }
DI float hi16(unsigned w) { return __uint_as_float(w & 0xffff0000u); }
DI float ex2(float x) { return __builtin_amdgcn_exp2f(x); }
DI float sigm(float x) { return __builtin_amdgcn_rcpf(1.f + ex2(-x * LOG2E)); }
DI int crow(int reg, int h) { return (reg & 3) + 8 * (reg >> 2) + 4 * h; }
DI int perm16(int k) { return ((k >> 2) & 1) * 8 + (k >> 3) * 4 + (k & 3); }
DI float wave_sum(float v) {
#pragma unroll
    for (int o = 1; o < 64; o <<= 1) v += __shfl_xor(v, o);
    return v;
}
DI float dpp_xor1(float v) { return __uint_as_float((unsigned)__builtin_amdgcn_update_dpp(0, (int)__float_as_uint(v), 0xB1, 0xF, 0xF, true)); }
DI float dpp_xor2(float v) { return __uint_as_float((unsigned)__builtin_amdgcn_update_dpp(0, (int)__float_as_uint(v), 0x4E, 0xF, 0xF, true)); }
DI bf16x8 pack8(const f32x16& x, int s) {
    u32x4 p; p.x = pk2(x[8 * s], x[8 * s + 1]); p.y = pk2(x[8 * s + 2], x[8 * s + 3]); p.z = pk2(x[8 * s + 4], x[8 * s + 5]); p.w = pk2(x[8 * s + 6], x[8 * s + 7]);
    return __builtin_bit_cast(bf16x8, p);
}
DI f32x16 zero16() { f32x16 z;
#pragma unroll
    for (int i = 0; i < 16; ++i) z[i] = 0.f;
    return z; }

#define XB_TMO      128
#define XB_XCNT(j)  (256  + 64 * (j))
#define XB_XSUB(j)  (1280 + 64 * (j))
#define XB_XGEN(j)  (2304 + 64 * (j))
#define XB_TOP      3328
#define XB_TOPGEN   3392
#define XCD_BAR_WORDS 3456
#define XB_SPIN_CAP (1u << 18)

__device__ __forceinline__ unsigned xb_ld(unsigned* p)              { return __hip_atomic_load(p, __ATOMIC_RELAXED, __HIP_MEMORY_SCOPE_AGENT); }
__device__ __forceinline__ unsigned xb_add(unsigned* p, unsigned v) { return __hip_atomic_fetch_add(p, v, __ATOMIC_RELAXED, __HIP_MEMORY_SCOPE_AGENT); }
__device__ __forceinline__ unsigned xb_xcc_id() { return (unsigned)__builtin_amdgcn_s_getreg((3 << 11) | 20) & 0xFu; }
#define XB_SPIN(cond, bar) do { unsigned _sp = 0; while (cond) { __builtin_amdgcn_s_sleep(1); \
    if ((++_sp & 255u) == 0u) { if (xb_ld(&(bar)[XB_TMO])) break; if (_sp > XB_SPIN_CAP) { atomicAdd(&(bar)[XB_TMO], 1u); break; } } } } while (0)

__device__ __forceinline__ int xb_lane() { int r; asm volatile("v_mbcnt_lo_u32_b32 %0, -1, 0\n\tv_mbcnt_hi_u32_b32 %0, -1, %0" : "=v"(r)); return r; }
struct XcdBarrier {
    unsigned* bar; unsigned x; int wave;
    volatile LAS unsigned* st;
};

__device__ __forceinline__ XcdBarrier xcd_barrier_post(unsigned* bar, volatile LAS unsigned* st, int wave) {
    XcdBarrier b; b.bar = bar; b.x = xb_xcc_id(); b.st = st; b.wave = wave;
    if (wave == 0 && xb_lane() == 0) (void)xb_add(&bar[XB_XCNT(b.x)], 1u);
    return b;
}
__device__ __forceinline__ void xcd_barrier_complete(unsigned* bar, unsigned x, unsigned& nloc, unsigned& nx) {
    const unsigned G = gridDim.x * gridDim.y * gridDim.z;
    unsigned sum, cnt, mine, sp = 0u;
    for (;;) {
        sum = 0u; cnt = 0u; mine = 0u;
#pragma unroll
        for (unsigned j = 0; j < 16; ++j) { const unsigned c = xb_ld(&bar[XB_XCNT(j)]); sum += c; cnt += (c > 0u) ? 1u : 0u; mine = (j == x) ? c : mine; }
        if (sum == G) break;
        __builtin_amdgcn_s_sleep(1);
        if ((++sp & 255u) == 0u) { if (xb_ld(&bar[XB_TMO])) break; if (sp > XB_SPIN_CAP) { atomicAdd(&bar[XB_TMO], 1u); break; } }
    }
    nloc = mine > 0u ? mine : 1u; nx = cnt > 0u ? cnt : 1u;
}

__device__ __forceinline__ void xcd_barrier(const XcdBarrier& b) {
    asm volatile("s_waitcnt vmcnt(0)" ::: "memory");
    __syncthreads();
    if (b.wave == 0 && xb_lane() == 0) {
        unsigned* bar = b.bar;
        __builtin_amdgcn_s_waitcnt(0);
        unsigned nloc = b.st[0], nx = b.st[1];
        if (nloc == 0u) { xcd_barrier_complete(bar, b.x, nloc, nx); b.st[0] = nloc; b.st[1] = nx; }
        const unsigned old = xb_add(&bar[XB_XSUB(b.x)], 1u);
        const unsigned gen = old / nloc;
        if (old + 1u == (gen + 1u) * nloc) {
            __builtin_amdgcn_fence(__ATOMIC_RELEASE, "agent");
            asm volatile("s_waitcnt vmcnt(0)" ::: "memory");
            const unsigned og = xb_add(&bar[XB_TOP], 1u);
            const unsigned tg = og / nx;
            if (og + 1u == (tg + 1u) * nx) xb_add(&bar[XB_TOPGEN], 1u);
            else XB_SPIN(xb_ld(&bar[XB_TOPGEN]) == tg, bar);
            __builtin_amdgcn_fence(__ATOMIC_ACQUIRE, "agent");
            xb_add(&bar[XB_XGEN(b.x)], 1u);
            asm volatile("s_waitcnt vmcnt(0)" ::: "memory");
        } else {
            XB_SPIN(xb_ld(&bar[XB_XGEN(b.x)]) == gen, bar);
            __builtin_amdgcn_fence(__ATOMIC_ACQUIRE, "agent");
            asm volatile("s_waitcnt vmcnt(0)" ::: "memory");
        }
    }
    __syncthreads();
}

struct EpiZ {
    static constexpr bool PERM = true, AFTER_DRAIN = false, HAS_MID = false;
    unsigned char* ws;
    DI void operator()(const f32x4 (&acc)[2][2][4][2], const pg8::Unit& u, int wr, int wc, int fr, int fq) const {
        const int pn = u.pn; bf16* base; int ld, c0; bool sig = false, narrow = false;
        if (pn < 2) { base = (bf16*)(ws + WS_ZQ); ld = 512; c0 = pn * 256; }
        else if (pn < 5) { base = (bf16*)(ws + WS_ZKV); ld = 768; c0 = (pn - 2) * 256; }
        else if (pn < 7) { base = (bf16*)(ws + WS_RQ); ld = 512; c0 = (pn - 5) * 256; }
        else if (pn < 9) { base = (bf16*)(ws + WS_RK); ld = 512; c0 = (pn - 7) * 256; }
        else if (pn < 11) { base = (bf16*)(ws + WS_RV); ld = 512; c0 = (pn - 9) * 256; }
        else if (pn < 13) { base = (bf16*)(ws + WS_RG); ld = 512; c0 = (pn - 11) * 256; }
        else if (pn < 21) { base = (bf16*)(ws + WS_ZM); ld = 2048; c0 = (pn - 13) * 128; sig = true; }
        else { base = (bf16*)(ws + WS_ZG); ld = 32; c0 = 0; sig = true; narrow = true; }
        const bool merge = (pn >= 13 && pn < 21);
        const int row0 = u.pm * 256 + wr * 64 + fr;
#pragma unroll
        for (int ai = 0; ai < 2; ++ai)
#pragma unroll
            for (int m = 0; m < 4; ++m) {
                bf16* rowp = base + (size_t)(row0 + ai * 128 + m * 16) * ld + c0 + (narrow ? 0 : wc * 32) + 8 * fq;
                if (merge) {
                    float rr[8], gg[8];
#pragma unroll
                    for (int n = 0; n < 2; ++n)
#pragma unroll
                        for (int e = 0; e < 4; ++e) {
                            const float e0 = fminf(ex2(-acc[ai][0][m][n][e] * LOG2E), 1e30f), e1 = fminf(ex2(-acc[ai][1][m][n][e] * LOG2E), 1e30f);
                            const float g1 = __builtin_amdgcn_rcpf(1.f + e1);
                            gg[n * 4 + e] = g1; rr[n * 4 + e] = (1.f + e1) * __builtin_amdgcn_rcpf(1.f + e0);
                        }
                    u32x4 w; w.x = pk2(rr[0], rr[1]); w.y = pk2(rr[2], rr[3]); w.z = pk2(rr[4], rr[5]); w.w = pk2(rr[6], rr[7]);
                    *(u32x4*)rowp = w;
                    w.x = pk2(gg[0], gg[1]); w.y = pk2(gg[2], gg[3]); w.z = pk2(gg[4], gg[5]); w.w = pk2(gg[6], gg[7]);
                    *(u32x4*)(rowp + 1024) = w;
                    continue;
                }
#pragma unroll
                for (int bj = 0; bj < 2; ++bj) {
                    if (narrow && (bj != 0 || wc != 0)) continue;
                    f32x4 v0 = acc[ai][bj][m][0], v1 = acc[ai][bj][m][1];
                    if (sig) {
#pragma unroll
                        for (int e = 0; e < 4; ++e) { v0[e] = sigm(v0[e]); v1[e] = sigm(v1[e]); }
                    }
                    u32x4 w; w.x = pk2(v0[0], v0[1]); w.y = pk2(v0[2], v0[3]); w.z = pk2(v1[0], v1[1]); w.w = pk2(v1[2], v1[3]);
                    *(u32x4*)(rowp + bj * 128) = w;
                }
            }
    }
};
struct EpiMix {
    static constexpr bool PERM = true, AFTER_DRAIN = false, HAS_MID = true;
    const bf16* zm; bf16* mix;
    DI void mid(f32x4 (&acc)[2][2][4][2], const pg8::Unit& u, int wr, int wc, int fr, int fq) const {
        const int row0 = u.pm * 256 + wr * 64 + fr, col0 = u.pn * 256 + wc * 32 + 8 * fq;
        const bf16* gp = zm + (size_t)row0 * 2048 + col0;
#pragma unroll
        for (int ai = 0; ai < 2; ++ai) {
#pragma unroll
            for (int m = 0; m < 4; ++m) {
                asm volatile("" : "+v"(gp));
#pragma unroll
                for (int bj = 0; bj < 2; ++bj) {
                    const u32x4 ga = __builtin_nontemporal_load((const u32x4*)(gp + bj * 128));
#pragma unroll
                    for (int e = 0; e < 4; ++e) {
                        acc[ai][bj][m][e >> 1][(e & 1) * 2] *= lo16(ga[e]); acc[ai][bj][m][e >> 1][(e & 1) * 2 + 1] *= hi16(ga[e]);
                    }
                }
                gp += (size_t)16 * 2048;
            }
            gp += (size_t)64 * 2048;
        }
    }
    DI void operator()(const f32x4 (&acc)[2][2][4][2], const pg8::Unit& u, int wr, int wc, int fr, int fq) const {
        const int row0 = u.pm * 256 + wr * 64 + fr, col0 = u.pn * 256 + wc * 32 + 8 * fq;
#pragma unroll
        for (int ai = 0; ai < 2; ++ai)
#pragma unroll
            for (int m = 0; m < 4; ++m) {
                const size_t row = (size_t)(row0 + ai * 128 + m * 16);
#pragma unroll
                for (int bj = 0; bj < 2; ++bj) {
                    const int col = col0 + bj * 128;
                    const u32x4 gt = __builtin_nontemporal_load((const u32x4*)(zm + row * 2048 + 1024 + col));
                    const f32x4 a0 = acc[ai][bj][m][0], a1 = acc[ai][bj][m][1];
                    u32x4 w; w.x = pk2(a0[0] * lo16(gt.x), a0[1] * hi16(gt.x)); w.y = pk2(a0[2] * lo16(gt.y), a0[3] * hi16(gt.y));
                    w.z = pk2(a1[0] * lo16(gt.z), a1[1] * hi16(gt.z)); w.w = pk2(a1[2] * lo16(gt.w), a1[3] * hi16(gt.w));
                    *(u32x4*)(mix + row * 1024 + col) = w;
                }
            }
    }
};
struct EpiOut {
    static constexpr bool PERM = true, AFTER_DRAIN = false, HAS_MID = false;
    const float* x; float* out; bf16* x1b; float* ssq;
    DI void operator()(const f32x4 (&acc)[2][2][4][2], const pg8::Unit& u, int wr, int wc, int fr, int fq) const {
        const int row0 = u.pm * 256 + wr * 64 + fr, col0 = u.pn * 256 + wc * 32 + 8 * fq;
#pragma unroll
        for (int ai = 0; ai < 2; ++ai)
#pragma unroll
            for (int m = 0; m < 4; ++m) {
                const size_t row = (size_t)(row0 + ai * 128 + m * 16);
                float ss = 0.f;
#pragma unroll
                for (int bj = 0; bj < 2; ++bj) {
                    const size_t off = row * 1024 + col0 + bj * 128;
                    const f32x4 v0 = acc[ai][bj][m][0] + __builtin_nontemporal_load((const f32x4*)(x + off)), v1 = acc[ai][bj][m][1] + __builtin_nontemporal_load((const f32x4*)(x + off + 4));
                    u32x4 w; w.x = pk2(v0[0], v0[1]); w.y = pk2(v0[2], v0[3]); w.z = pk2(v1[0], v1[1]); w.w = pk2(v1[2], v1[3]);
                    *(u32x4*)(x1b + off) = w;
                    ss += (v0[0] * v0[0] + v0[1] * v0[1]) + (v0[2] * v0[2] + v0[3] * v0[3]) + (v1[0] * v1[0] + v1[1] * v1[1]) + (v1[2] * v1[2] + v1[3] * v1[3]);
                }
                ss += __shfl_xor(ss, 16); ss += __shfl_xor(ss, 32);
                if (fq == 0) ssq[row * 16 + u.pn * 4 + wc] = ss;
            }
    }
};
struct EpiFfn {
    static constexpr bool PERM = true, AFTER_DRAIN = false, HAS_MID = false;
    const LAS float* rstd_tab; bf16* hid; const float* ssq; int pm0;
    DI void operator()(const f32x4 (&acc)[2][2][4][2], const pg8::Unit& u, int wr, int wc, int fr, int fq) const {
        const int row0 = u.pm * 256 + wr * 64 + fr, col0 = u.pn * 128 + wc * 32 + 8 * fq;
#pragma unroll
        for (int ai = 0; ai < 2; ++ai)
#pragma unroll
            for (int m = 0; m < 4; ++m) {
                const size_t row = (size_t)(row0 + ai * 128 + m * 16);
                float rstd;
                if (u.pm == pm0) rstd = rstd_tab[wr * 64 + fr + ai * 128 + m * 16];
                else {
                    const float* sp = ssq + row * 16; float tot = 0.f;
#pragma unroll
                    for (int k = 0; k < 16; ++k) tot += sp[k];
                    rstd = rsqrtf(tot * (1.f / 1024.f) + EPS);
                }
                float v[8];
#pragma unroll
                for (int n = 0; n < 2; ++n)
#pragma unroll
                    for (int e = 0; e < 4; ++e) { const float gg = acc[ai][0][m][n][e] * rstd, uu = acc[ai][1][m][n][e] * rstd; v[n * 4 + e] = gg * sigm(gg) * uu; }
                u32x4 w; w.x = pk2(v[0], v[1]); w.y = pk2(v[2], v[3]); w.z = pk2(v[4], v[5]); w.w = pk2(v[6], v[7]);
                *(u32x4*)(hid + row * DFF + col0) = w;
            }
    }
};
struct EpiDown {
    static constexpr bool PERM = true, AFTER_DRAIN = false, HAS_MID = false;
    float* out; const bf16* x1b; int dry;
    DI void operator()(const f32x4 (&acc)[2][2][4][2], const pg8::Unit& u, int wr, int wc, int fr, int fq) const {
        const int row0 = u.pm * 256 + wr * 64 + fr, col0 = u.pn * 256 + wc * 32 + 8 * fq;
#pragma unroll
        for (int ai = 0; ai < 2; ++ai)
#pragma unroll
            for (int m = 0; m < 4; ++m) {
                const size_t row = (size_t)(row0 + ai * 128 + m * 16);
#pragma unroll
                for (int bj = 0; bj < 2; ++bj) {
                    float* p = out + row * 1024 + col0 + bj * 128;
                    const u32x4 xr = __builtin_nontemporal_load((const u32x4*)(x1b + row * 1024 + col0 + bj * 128));
                    const f32x4 v0 = acc[ai][bj][m][0] + (f32x4){lo16(xr.x), hi16(xr.x), lo16(xr.y), hi16(xr.y)}, v1 = acc[ai][bj][m][1] + (f32x4){lo16(xr.z), hi16(xr.z), lo16(xr.w), hi16(xr.w)};
                    if (!dry) { __builtin_nontemporal_store(v0, (f32x4*)p); __builtin_nontemporal_store(v1, (f32x4*)(p + 4)); }
                }
            }
    }
};

template <class F> DI void tr_item(LAS float* scr, int lane, F src4, bf16* WT, int Kdst, int k0, int n0) {
    f32x4 v[8];
#pragma unroll
    for (int i = 0; i < 8; ++i) v[i] = src4(k0 + i * 8 + (lane >> 3), n0 + 4 * (lane & 7));
#pragma unroll
    for (int i = 0; i < 8; ++i) { LAS float* d = scr + (i * 8 + (lane >> 3)) * 33 + 4 * (lane & 7); d[0] = v[i][0]; d[1] = v[i][1]; d[2] = v[i][2]; d[3] = v[i][3]; }
    LDS_WAIT();
    const int c = lane & 7;
#pragma unroll
    for (int jj = 0; jj < 4; ++jj) {
        const int n = (lane >> 3) + 8 * jj; const LAS float* s = scr + (8 * c) * 33 + n;
        u32x4 o; o.x = pk2(s[0], s[33]); o.y = pk2(s[66], s[99]); o.z = pk2(s[132], s[165]); o.w = pk2(s[198], s[231]);
        *(u32x4*)(WT + (size_t)(n0 + n) * Kdst + k0 + 8 * c) = o;
    }
    LDS_WAIT();
}
DI void phase0(const Args& A, LAS unsigned char* lds, int tid, int lane, int wave, const int part, const int gw, const int NGW) {
    LAS float* scr = (LAS float*)(lds + wave * 16384);
    constexpr int I_IN = 16 * 176, I_GU = 16 * 176, I_DN = 44 * 32, I_WB = 2 * 8 * 32, I_WO = 16 * 32, I_W1 = 2 * 32 * 4 + 8;
    constexpr int NITEMS = I_IN + I_GU + I_DN + I_WB + I_WO + I_W1;
    unsigned char* ws = A.ws;
    for (int it = gw; it < NITEMS; it += NGW) {
        int r = it;
        const bool early = (r < I_IN) || (r >= NITEMS - I_W1);
        if (early != (part == 0)) continue;
        if (r < I_IN) {
            const float* W = A.win;
            auto src = [=](int k, int n) -> f32x4 {
                int c; if (n < 1280) c = n; else if (n < 3328) c = n + 24;
                else if (n < 5376) { const int q = n - 3328; c = 3352 + ((q >> 7) & 1) * 1024 + (q >> 8) * 128 + (q & 127); }
                else if (n < 5400) c = n - 5376 + 1280; else c = -1;
                return c >= 0 ? __builtin_nontemporal_load((const f32x4*)(W + (size_t)k * NIN + c)) : (f32x4){0.f, 0.f, 0.f, 0.f}; };
            tr_item(scr, lane, src, (bf16*)(ws + WS_WIN), 1024, (r / 176) * 64, (r % 176) * 32); continue; }
        r -= I_IN;
        if (r < I_GU) {
            const float* Wg = A.wg; const float* Wu = A.wu; const float* g2 = A.n2g;
            auto src = [=](int k, int n) -> f32x4 { const int tile = n >> 8, within = n & 255, j = tile * 128 + (within & 127);
                return g2[k] * __builtin_nontemporal_load((const f32x4*)(((within >> 7) ? Wu : Wg) + (size_t)k * DFF + j)); };
            tr_item(scr, lane, src, (bf16*)(ws + WS_WGU), 1024, (r / 176) * 64, (r % 176) * 32); continue; }
        r -= I_GU;
        if (r < I_DN) {
            const float* W = A.wd;
            auto src = [=](int k, int n) -> f32x4 { return __builtin_nontemporal_load((const f32x4*)(W + (size_t)k * 1024 + n)); };
            tr_item(scr, lane, src, (bf16*)(ws + WS_WDN), DFF, (r / 32) * 64, (r % 32) * 32); continue; }
        r -= I_DN;
        if (r < I_WB) {
            const float* W = A.wb;
            auto src = [=](int k, int n) -> f32x4 { return __builtin_nontemporal_load((const f32x4*)(W + (size_t)k * 1024 + n)); };
            tr_item(scr, lane, src, (bf16*)(ws + WS_WB), 1024, (r / 32) * 64, (r % 32) * 32); continue; }
        r -= I_WB;
        if (r < I_WO) {
            const float* W = A.wo;
            auto src = [=](int k, int n) -> f32x4 { return __builtin_nontemporal_load((const f32x4*)(W + (size_t)k * 1024 + n)); };
            tr_item(scr, lane, src, (bf16*)(ws + WS_WO), 1024, (r / 32) * 64, (r % 32) * 32); continue; }
        r -= I_WO;
        if (r >= 256) {
            const int which = (r - 256) >> 2, rr = (r - 256) & 3; const float* W = A.w2 + (size_t)which * 128 * 64;
            auto src = [=](int k, int n) -> f32x4 { return *(const f32x4*)(W + (size_t)k * 64 + n); };
            tr_item(scr, lane, src, (bf16*)(ws + WS_W2T) + (size_t)which * 64 * 128, 128, (rr >> 1) * 64, (rr & 1) * 32);
        } else {
            const int which = r / 128, rr = r % 128; const float* W = A.w1 + (size_t)which * 2048 * 128;
            auto src = [=](int k, int n) -> f32x4 { return *(const f32x4*)(W + (size_t)k * 128 + n); };
            tr_item(scr, lane, src, (bf16*)(ws + WS_W1T) + (size_t)which * 128 * 2048, 2048, (rr / 4) * 64, (rr % 4) * 32);
        }
    }
    if (part != 0) return;
    bf16* H = (bf16*)(ws + WS_H);
    f32x4 gv[4];
#pragma unroll
    for (int j = 0; j < 4; ++j) gv[j] = ((const f32x4*)A.n1g)[lane + 64 * j];
    for (int m = gw; m < M; m += 2 * NGW) {
        const int m2 = m + NGW; const bool has2 = m2 < M;
        const f32x4* xr = (const f32x4*)(A.x + (size_t)m * DM) + lane;
        const f32x4* xr2 = (const f32x4*)(A.x + (size_t)(has2 ? m2 : m) * DM) + lane;
        f32x4 v[4], w[4]; float s = 0.f, s2 = 0.f;
#pragma unroll
        for (int j = 0; j < 4; ++j) { v[j] = __builtin_nontemporal_load(xr + 64 * j); w[j] = __builtin_nontemporal_load(xr2 + 64 * j); }
#pragma unroll
        for (int j = 0; j < 4; ++j) { s += (v[j][0] * v[j][0] + v[j][1] * v[j][1]) + (v[j][2] * v[j][2] + v[j][3] * v[j][3]); s2 += (w[j][0] * w[j][0] + w[j][1] * w[j][1]) + (w[j][2] * w[j][2] + w[j][3] * w[j][3]); }
        const float rstd = rsqrtf(wave_sum(s) * (1.f / DM) + EPS), rstd2 = rsqrtf(wave_sum(s2) * (1.f / DM) + EPS);
        u32x2* o8 = (u32x2*)(H + (size_t)m * DM) + lane;
#pragma unroll
        for (int j = 0; j < 4; ++j) { u32x2 ww; ww.x = pk2(v[j][0] * rstd * gv[j][0], v[j][1] * rstd * gv[j][1]); ww.y = pk2(v[j][2] * rstd * gv[j][2], v[j][3] * rstd * gv[j][3]); o8[64 * j] = ww; }
        if (has2) {
            u32x2* p8 = (u32x2*)(H + (size_t)m2 * DM) + lane;
#pragma unroll
            for (int j = 0; j < 4; ++j) { u32x2 ww; ww.x = pk2(w[j][0] * rstd2 * gv[j][0], w[j][1] * rstd2 * gv[j][1]); ww.y = pk2(w[j][2] * rstd2 * gv[j][2], w[j][3] * rstd2 * gv[j][3]); p8[64 * j] = ww; }
        }
    }
    const int gt = blockIdx.x * 512 + tid;
    if (gt < 8192) {
        const int kv = gt >> 12, l = (gt >> 7) & 31, f = gt & 127;
        const float* pe = A.pe + (kv * 32 + l) * 64; const float* w1 = A.w1 + ((size_t)(kv * 32 + l) * 64) * 128 + f;
        float s = 0.f;
#pragma unroll 8
        for (int d = 0; d < 64; ++d) s += pe[d] * w1[(size_t)d * 128];
        ((float*)(ws + WS_BIASP))[gt] = s;
    }
}

DI void kvprep_unit(const Args& A, LAS unsigned char* lds, int u, int lane, int wave) {
    unsigned char* ws = A.ws;
    const int b = u >> 5, tile = u & 31;
    const int br = 1 + (wave >> 2), g = (wave >> 1) & 1, kind = wave & 1;
    const int tl = lane >> 3, ch = lane & 7;
    const bf16* src = (const bf16*)(ws + WS_ZKV) + (size_t)(b * SEQ + tile * 64 + tl) * 768 + br * 256 + kind * 128 + g * 64 + 8 * ch;
    u32x4 v[8];
#pragma unroll
    for (int it = 0; it < 8; ++it) v[it] = __builtin_nontemporal_load((const u32x4*)(src + (size_t)it * 8 * 768));
    const size_t slab = (size_t)(((br - 1) * 8 + b) * 2 + g);
    if (kind == 0) {
        const float* kg = A.kg + br * 64 + 8 * ch;
        float kgv[8];
#pragma unroll
        for (int e = 0; e < 8; ++e) kgv[e] = kg[e];
        bf16* dst = (bf16*)(ws + WS_KN) + (slab * 2048 + tile * 64 + tl) * 64 + 8 * ch;
#pragma unroll
        for (int it = 0; it < 8; ++it) {
            float ss = 0.f;
#pragma unroll
            for (int e = 0; e < 4; ++e) { const float a = lo16(v[it][e]), c = hi16(v[it][e]); ss += a * a + c * c; }
            ss += __shfl_xor(ss, 1); ss += __shfl_xor(ss, 2); ss += __shfl_xor(ss, 4);
            const float rstd = rsqrtf(ss * (1.f / 64.f) + EPS);
            u32x4 w;
#pragma unroll
            for (int e = 0; e < 4; ++e) w[e] = pk2(lo16(v[it][e]) * rstd * kgv[2 * e], hi16(v[it][e]) * rstd * kgv[2 * e + 1]);
            *(u32x4*)(dst + (size_t)it * 8 * 64) = w;
        }
    } else {
        LAS unsigned char* T = lds + wave * 9344;
#pragma unroll
        for (int it = 0; it < 8; ++it) {
            const int t = it * 8 + tl, pos = (t & ~15) | perm16(t & 15);
#pragma unroll
            for (int e = 0; e < 4; ++e) {
                const int d0 = 8 * ch + 2 * e;
                *(LAS bf16*)(T + d0 * 144 + ch * 16 + pos * 2) = (bf16)(v[it][e] & 0xffffu);
                *(LAS bf16*)(T + (d0 + 1) * 144 + ch * 16 + pos * 2) = (bf16)(v[it][e] >> 16);
            }
        }
        LDS_WAIT();
        bf16* dst = (bf16*)(ws + WS_VT) + slab * 64 * 2048 + tile * 64;
#pragma unroll
        for (int q = 0; q < 8; ++q) { const int idx = q * 64 + lane, d = idx >> 3, c8 = idx & 7;
            const u32x4 w = *(const LAS u32x4*)(T + d * 144 + (d >> 3) * 16 + c8 * 16);
            *(u32x4*)(dst + (size_t)d * 2048 + c8 * 8) = w; }
        LDS_WAIT();
    }
    __syncthreads();
}

DI float gelu_tanh(float x) {
    const float y = 0.7978845608028654f * (x + 0.044715f * x * x * x);
    const float e = ex2(2.f * LOG2E * y);
    const float t = 1.f - 2.f * __builtin_amdgcn_rcpf(e + 1.f);
    return 0.5f * x * (1.f + t);
}
DI void compress_unit(const Args& A, LAS unsigned char* lds, int u, int tid, int lane, int wave) {
    unsigned char* ws = A.ws;
    const int b = u >> 4, g = (u >> 3) & 1, kv = (u >> 2) & 1, nq = u & 3;
    const int r = lane & 31, h = lane >> 5, fb = wave & 3, kh = wave >> 2;
    const int n0 = nq * 32;
    LAS unsigned char* XL = lds;
    LAS float* RED = (LAS float*)(lds + 77824);
    {
        const bf16* xs = (const bf16*)(ws + WS_ZKV) + (size_t)(b * SEQ) * 768 + kv * 128 + g * 64 + 8 * (tid & 7);
#pragma unroll
        for (int q = 0; q < 9; ++q) {
            const int t = q * 64 + (tid >> 3);
            if (t < 528) {
                const int tok = 16 * n0 + t;
                u32x4 v = (u32x4){0u, 0u, 0u, 0u};
                if (tok < SEQ) v = __builtin_nontemporal_load((const u32x4*)(xs + (size_t)tok * 768));
                *(LAS u32x4*)(XL + t * 144 + (t >> 4) * 16 + (tid & 7) * 16) = v;
            }
        }
    }
    float bias = 0.f;
    if (kh == 0) {
        const float* bp2 = (const float*)(ws + WS_BIASP) + kv * 32 * 128 + fb * 32 + r;
#pragma unroll
        for (int l = 0; l < 32; ++l) bias += bp2[l * 128];
    }
    const bf16* bp = (const bf16*)(ws + WS_W1T) + (size_t)(kv * 128 + fb * 32 + r) * 2048 + 8 * h;
    f32x16 acc = zero16();
    u32x4 bv[8][4];
#pragma unroll
    for (int li = 0; li < 8; ++li)
#pragma unroll
        for (int j = 0; j < 4; ++j) bv[li][j] = *(const u32x4*)(bp + (kh * 16 + li) * 64 + 16 * j);
    __syncthreads();
#pragma unroll 1
    for (int l0 = kh * 16; l0 < kh * 16 + 16; l0 += 8) {
        if (l0 != kh * 16) {
#pragma unroll
            for (int li = 0; li < 8; ++li)
#pragma unroll
                for (int j = 0; j < 4; ++j) bv[li][j] = *(const u32x4*)(bp + (l0 + li) * 64 + 16 * j);
        }
#pragma unroll
        for (int li = 0; li < 8; ++li) {
            const int t = 16 * r + l0 + li;
#pragma unroll
            for (int j = 0; j < 4; ++j) {
                const bf16x8 a = *(const LAS bf16x8*)(XL + t * 144 + (t >> 4) * 16 + (16 * j + 8 * h) * 2);
                acc = MFMA32(a, __builtin_bit_cast(bf16x8, bv[li][j]), acc);
            }
        }
    }
    if (kh == 1) {
#pragma unroll
        for (int reg = 0; reg < 16; ++reg) RED[crow(reg, h) * 132 + fb * 32 + r] = acc[reg];
    }
    __syncthreads();
    if (kh == 0) {
        const int f = fb * 32 + r;
#pragma unroll
        for (int reg = 0; reg < 16; ++reg) { const int o = crow(reg, h) * 132 + f; RED[o] = gelu_tanh(acc[reg] + RED[o] + bias); }
    }
    __syncthreads();
    if (wave == 0) {
        const bf16* w2t = (const bf16*)(ws + WS_W2T) + (size_t)(kv * 64 + r) * 128 + 8 * h;
        u32x4 wv[2][8];
#pragma unroll
        for (int db = 0; db < 2; ++db)
#pragma unroll
            for (int ks = 0; ks < 8; ++ks) wv[db][ks] = *(const u32x4*)(w2t + (size_t)db * 32 * 128 + ks * 16);
        f32x16 o0 = zero16(), o1 = zero16();
#pragma unroll
        for (int ks = 0; ks < 8; ++ks) {
            const f32x4 x0 = *(const LAS f32x4*)(RED + r * 132 + ks * 16 + 8 * h), x1 = *(const LAS f32x4*)(RED + r * 132 + ks * 16 + 8 * h + 4);
            u32x4 aw; aw.x = pk2(x0[0], x0[1]); aw.y = pk2(x0[2], x0[3]); aw.z = pk2(x1[0], x1[1]); aw.w = pk2(x1[2], x1[3]);
            const bf16x8 af = __builtin_bit_cast(bf16x8, aw);
            o0 = MFMA32(af, __builtin_bit_cast(bf16x8, wv[0][ks]), o0);
            o1 = MFMA32(af, __builtin_bit_cast(bf16x8, wv[1][ks]), o1);
        }
        const size_t bg = (size_t)(b * 2 + g);
        if (kv == 0) {
            const float kg0 = A.kg[r], kg1 = A.kg[32 + r];
#pragma unroll
            for (int reg = 0; reg < 16; ++reg) {
                float ss = o0[reg] * o0[reg] + o1[reg] * o1[reg];
                ss += __shfl_xor(ss, 1); ss += __shfl_xor(ss, 2); ss += __shfl_xor(ss, 4); ss += __shfl_xor(ss, 8); ss += __shfl_xor(ss, 16);
                const float rstd = rsqrtf(ss * (1.f / 64.f) + EPS); const int nn = n0 + crow(reg, h);
                bf16* dst = (bf16*)(ws + WS_KC) + (bg * 128 + nn) * 64;
                dst[r] = f2bf(nn < 127 ? o0[reg] * rstd * kg0 : 0.f); dst[32 + r] = f2bf(nn < 127 ? o1[reg] * rstd * kg1 : 0.f);
            }
        } else {
#pragma unroll
            for (int reg = 0; reg < 16; ++reg) {
                const int nn = n0 + crow(reg, h), pp = (nn & ~15) | perm16(nn & 15);
                bf16* dst = (bf16*)(ws + WS_VCT) + bg * 64 * 128 + pp;
                dst[(size_t)r * 128] = f2bf(nn < 127 ? o0[reg] : 0.f); dst[(size_t)(32 + r) * 128] = f2bf(nn < 127 ? o1[reg] : 0.f);
            }
        }
    }
    __syncthreads();
}

DI void rstate_group(const Args& A, LAS unsigned char* lds, int ug, int tid, int lane, int wave) {
    unsigned char* ws = A.ws;
    const int b = ug >> 4, hh = (ug >> 2) & 3, mg = ug & 3;
    LAS bf16* KT = (LAS bf16*)lds;
    LAS bf16* VTL = (LAS bf16*)(lds + 35328);
    const float lg = log2f(1.f - exp2f(-5.f - (float)hh));
    const float cd = ex2(128.f * lg);
    const int r = lane & 31, h = lane >> 5, eb = wave >> 1;
    f32x16 R0 = zero16(), R1 = zero16();
    u32x4 kxv[4], vxv[4];
#pragma unroll
    for (int q = 0; q < 4; ++q) {
        const int idx = q * 512 + tid, j = idx >> 4, ch = idx & 15;
        const size_t row = (size_t)(b * SEQ + (mg * 4) * 128 + j) * 512 + hh * 128 + ch * 8;
        kxv[q] = *(const u32x4*)((const bf16*)(ws + WS_RK) + row); vxv[q] = *(const u32x4*)((const bf16*)(ws + WS_RV) + row);
    }
#pragma unroll 1
    for (int k = 0; k < 4; ++k) {
        const int c = mg * 4 + k;
#pragma unroll
        for (int q = 0; q < 4; ++q) {
            const int idx = q * 512 + tid, j = idx >> 4, ch = idx & 15;
            const u32x4 kx = kxv[q], vx = vxv[q];
            const float sc = ex2((float)(127 - j) * lg) * 0.08838834764831845f;
#pragma unroll
            for (int e = 0; e < 4; ++e) {
                KT[(ch * 8 + 2 * e) * 136 + ch * 8 + j] = f2bf(lo16(kx[e]) * sc); KT[(ch * 8 + 2 * e + 1) * 136 + ch * 8 + j] = f2bf(hi16(kx[e]) * sc);
                VTL[(ch * 8 + 2 * e) * 136 + ch * 8 + j] = (bf16)(vx[e] & 0xffffu); VTL[(ch * 8 + 2 * e + 1) * 136 + ch * 8 + j] = (bf16)(vx[e] >> 16);
            }
        }
        if (k < 3) {
#pragma unroll
            for (int q = 0; q < 4; ++q) {
                const int idx = q * 512 + tid, j = idx >> 4, ch = idx & 15;
                const size_t row = (size_t)(b * SEQ + (c + 1) * 128 + j) * 512 + hh * 128 + ch * 8;
                kxv[q] = *(const u32x4*)((const bf16*)(ws + WS_RK) + row); vxv[q] = *(const u32x4*)((const bf16*)(ws + WS_RV) + row);
            }
        }
        __syncthreads();
        bf16* dst = (bf16*)(ws + WS_KVT) + (size_t)((b * 4 + hh) * 16 + c) * 16384;
#pragma unroll
        for (int dbi = 0; dbi < 2; ++dbi) {
            const int db = (wave & 1) * 2 + dbi; f32x16 acc = zero16();
#pragma unroll
            for (int ks = 0; ks < 8; ++ks) {
                const bf16x8 a = *(const LAS bf16x8*)(VTL + (eb * 32 + r) * 136 + ((eb * 32 + r) >> 3) * 8 + ks * 16 + 8 * h);
                const bf16x8 bb = *(const LAS bf16x8*)(KT + (db * 32 + r) * 136 + ((db * 32 + r) >> 3) * 8 + ks * 16 + 8 * h);
                acc = MFMA32(a, bb, acc);
            }
            if (dbi == 0) {
#pragma unroll
                for (int reg = 0; reg < 16; ++reg) { R0[reg] = R0[reg] * cd + acc[reg]; dst[(size_t)(eb * 32 + crow(reg, h)) * 128 + db * 32 + r] = f2bf(R0[reg]); }
            } else {
#pragma unroll
                for (int reg = 0; reg < 16; ++reg) { R1[reg] = R1[reg] * cd + acc[reg]; dst[(size_t)(eb * 32 + crow(reg, h)) * 128 + db * 32 + r] = f2bf(R1[reg]); }
            }
        }
        __syncthreads();
    }
}

DI void rout_unit(const Args& A, LAS unsigned char* lds, int u, int tid, int lane, int wave, const bool dry) {
    unsigned char* ws = A.ws;
    const int b = u >> 6, hh = (u >> 4) & 3, c = u & 15;
    LAS bf16* KL = (LAS bf16*)lds;
    LAS bf16* VTL = (LAS bf16*)(lds + 34816);
    LAS bf16* STL = (LAS bf16*)(lds + 70144);
    const float lg = log2f(1.f - exp2f(-5.f - (float)hh));
    u32x4 qraw[8]; u32x2 graw[16];
    if (wave < 4) {
        const int r_ = lane & 31, h_ = lane >> 5;
        const size_t tok_ = (size_t)(b * SEQ + c * 128 + wave * 32 + r_);
        const bf16* qp_ = (const bf16*)(ws + WS_RQ) + tok_ * 512 + hh * 128 + 8 * h_;
        const bf16* gp_ = (const bf16*)(ws + WS_RG) + tok_ * 512 + hh * 128 + 4 * h_;
#pragma unroll
        for (int ks = 0; ks < 8; ++ks) qraw[ks] = __builtin_nontemporal_load((const u32x4*)(qp_ + ks * 16));
#pragma unroll
        for (int eb = 0; eb < 4; ++eb)
#pragma unroll
            for (int g4 = 0; g4 < 4; ++g4) graw[eb * 4 + g4] = __builtin_nontemporal_load((const u32x2*)(gp_ + eb * 32 + 8 * g4));
    }
    {
        float sa[4][8];
#pragma unroll
        for (int q = 0; q < 4; ++q)
#pragma unroll
            for (int e = 0; e < 8; ++e) sa[q][e] = 0.f;
#pragma unroll
        for (int q = 0; q < 4; ++q) {
            const int idx = q * 512 + tid, j = idx >> 4, ch = idx & 15;
            const size_t row = (size_t)(b * SEQ + c * 128 + j) * 512 + hh * 128 + ch * 8;
            const u32x4 kx = *(const u32x4*)((const bf16*)(ws + WS_RK) + row), vx = *(const u32x4*)((const bf16*)(ws + WS_RV) + row);
            *(LAS u32x4*)(KL + j * 136 + ch * 8) = kx;
            const int pos = (j & ~15) | perm16(j & 15);
#pragma unroll
            for (int e = 0; e < 4; ++e) { VTL[(ch * 8 + 2 * e) * 136 + ch * 8 + pos] = (bf16)(vx[e] & 0xffffu); VTL[(ch * 8 + 2 * e + 1) * 136 + ch * 8 + pos] = (bf16)(vx[e] >> 16); }
        }
        const bf16* kvt = (const bf16*)(ws + WS_KVT) + (size_t)((b * 4 + hh) * 16) * 16384;
        {
            const int mg = c >> 2;
            int cps[4]; float wts[4];
            cps[0] = (c & 3) ? c - 1 : 0; wts[0] = (c & 3) ? 1.f : 0.f;
#pragma unroll
            for (int k = 1; k < 4; ++k) { const int mp = k - 1; cps[k] = (mp < mg) ? 4 * mp + 3 : 0; wts[k] = (mp < mg) ? ex2(128.f * (float)(c - 4 * mp - 4) * lg) : 0.f; }
            u32x4 xx[4][4];
#pragma unroll
            for (int k = 0; k < 4; ++k)
#pragma unroll
                for (int q = 0; q < 4; ++q) xx[k][q] = *(const u32x4*)(kvt + (size_t)cps[k] * 16384 + (q * 512 + tid) * 8);
#pragma unroll
            for (int k = 0; k < 4; ++k)
#pragma unroll
                for (int q = 0; q < 4; ++q)
#pragma unroll
                    for (int e = 0; e < 4; ++e) { sa[q][2 * e] += wts[k] * lo16(xx[k][q][e]); sa[q][2 * e + 1] += wts[k] * hi16(xx[k][q][e]); }
        }
#pragma unroll
        for (int q = 0; q < 4; ++q) {
            const int idx = q * 512 + tid, e = idx >> 4, ch = idx & 15;
            u32x4 w; w.x = pk2(sa[q][0], sa[q][1]); w.y = pk2(sa[q][2], sa[q][3]); w.z = pk2(sa[q][4], sa[q][5]); w.w = pk2(sa[q][6], sa[q][7]);
            *(LAS u32x4*)(STL + e * 136 + ch * 8) = w;
        }
    }
    __syncthreads();
    if (wave < 4) {
        const int r = lane & 31, h = lane >> 5, ib = wave, i = ib * 32 + r;
        const size_t tok = (size_t)(b * SEQ + c * 128 + i);
        bf16x8 qf[8], qdf[8];
        {
            const bf16* qp = (const bf16*)(ws + WS_RQ) + tok * 512 + hh * 128 + 8 * h;
            const float qd = ex2((float)(i + 1) * lg);
#pragma unroll
            for (int ks = 0; ks < 8; ++ks) {
                const u32x4 xx = qraw[ks];
                qf[ks] = __builtin_bit_cast(bf16x8, xx);
                u32x4 y;
#pragma unroll
                for (int e = 0; e < 4; ++e) y[e] = pk2(lo16(xx[e]) * qd, hi16(xx[e]) * qd);
                qdf[ks] = __builtin_bit_cast(bf16x8, y);
            }
        }
        f32x16 o[4];
#pragma unroll
        for (int eb = 0; eb < 4; ++eb) o[eb] = zero16();
#pragma unroll
        for (int jb = 0; jb < 4; ++jb) {
            if (jb <= ib) {
                f32x16 s = zero16();
#pragma unroll
                for (int ks = 0; ks < 8; ++ks) s = MFMA32(*(const LAS bf16x8*)(KL + (jb * 32 + r) * 136 + ks * 16 + 8 * h), qf[ks], s);
#pragma unroll
                for (int reg = 0; reg < 16; ++reg) { const int diff = i - (jb * 32 + crow(reg, h));
                    s[reg] *= (diff >= 0) ? ex2((float)diff * lg) * 0.08838834764831845f : 0.f; }
#pragma unroll
                for (int s2 = 0; s2 < 2; ++s2) {
                    const bf16x8 pf = pack8(s, s2);
#pragma unroll
                    for (int eb = 0; eb < 4; ++eb) o[eb] = MFMA32(*(const LAS bf16x8*)(VTL + (eb * 32 + r) * 136 + ((eb * 32 + r) >> 3) * 8 + jb * 32 + s2 * 16 + 8 * h), pf, o[eb]);
                }
            }
        }
#pragma unroll
        for (int eb = 0; eb < 4; ++eb)
#pragma unroll
            for (int ks = 0; ks < 8; ++ks) o[eb] = MFMA32(*(const LAS bf16x8*)(STL + (eb * 32 + r) * 136 + ks * 16 + 8 * h), qdf[ks], o[eb]);
        float sm = 0.f;
#pragma unroll
        for (int eb = 0; eb < 4; ++eb)
#pragma unroll
            for (int reg = 0; reg < 16; ++reg) sm += o[eb][reg];
        sm += __shfl_xor(sm, 32);
        const float mu = sm * (1.f / 128.f);
        float vq = 0.f;
#pragma unroll
        for (int eb = 0; eb < 4; ++eb)
#pragma unroll
            for (int reg = 0; reg < 16; ++reg) { const float dd = o[eb][reg] - mu; vq += dd * dd; }
        vq += __shfl_xor(vq, 32);
        const float rstd = rsqrtf(vq * (1.f / 128.f) + EPS);
        const bf16* gp = (const bf16*)(ws + WS_RG) + tok * 512 + hh * 128;
        bf16* yp = (bf16*)(ws + WS_Y) + tok * 1024 + 512 + hh * 128;
        const float* gn = A.gng + hh * 128;
#pragma unroll
        for (int eb = 0; eb < 4; ++eb)
#pragma unroll
            for (int g4 = 0; g4 < 4; ++g4) {
                const int e0 = eb * 32 + 8 * g4 + 4 * h;
                const u32x2 gv = graw[eb * 4 + g4]; const f32x4 gw = *(const f32x4*)(gn + e0);
                float y[4];
#pragma unroll
                for (int k = 0; k < 4; ++k) { const float gg = (k & 1) ? hi16(gv[k >> 1]) : lo16(gv[k >> 1]); y[k] = (o[eb][4 * g4 + k] - mu) * rstd * gw[k] * (gg * sigm(gg)); }
                u32x2 w; w.x = pk2(y[0], y[1]); w.y = pk2(y[2], y[3]);
                if (!dry) *(u32x2*)(yp + e0) = w;
            }
    }
    __syncthreads();
}

DI bf16x8 aug_k(int off, int h) {
    const unsigned o = (unsigned)f2bf((float)off);
    u32x4 w; w.x = h ? 0u : (o | (o << 16)); w.y = h ? 0u : 0x3f803f80u; w.z = h ? 0u : 0x00003f80u; w.w = 0u;
    return __builtin_bit_cast(bf16x8, w);
}
DI bf16x8 aug_q(unsigned slope_pk, float base, int h) {
    const unsigned b0 = (unsigned)f2bf(base); const float r1 = base - bf2f((unsigned short)b0);
    const unsigned b1 = (unsigned)f2bf(r1); const float r2 = r1 - bf2f((unsigned short)b1);
    const unsigned b2 = (unsigned)f2bf(r2);
    u32x4 w; w.x = h ? 0u : slope_pk; w.y = h ? 0u : (b0 | (b1 << 16)); w.z = h ? 0u : b2; w.w = 0u;
    return __builtin_bit_cast(bf16x8, w);
}
DI void nsa_tile(const int MASK, LAS unsigned char* kbuf, LAS unsigned char* vbuf, const bf16x8 (&qf)[4], const bf16x8 (&ka)[2], bf16x8 qa, int kt, int tq, int r, int h,
                 float& l, f32x16& o0, f32x16& o1) {
    bf16x8 kf[8];
#pragma unroll
    for (int j = 0; j < 4; ++j) { kf[2 * j] = *(const LAS bf16x8*)(kbuf + r * 144 + (16 * j + 8 * h) * 2); kf[2 * j + 1] = *(const LAS bf16x8*)(kbuf + (32 + r) * 144 + (16 * j + 8 * h) * 2); }
    __builtin_amdgcn_sched_barrier(0);
    f32x16 s0 = zero16(), s1 = zero16();
#pragma unroll
    for (int j = 0; j < 4; ++j) { s0 = MFMA32(kf[2 * j], qf[j], s0); s1 = MFMA32(kf[2 * j + 1], qf[j], s1); }
    s0 = MFMA32(ka[0], qa, s0); s1 = MFMA32(ka[1], qa, s1);
    bf16x8 vf[8];
#pragma unroll
    for (int s2 = 0; s2 < 2; ++s2) {
        vf[4 * s2 + 0] = *(const LAS bf16x8*)(vbuf + r * 144 + (s2 * 16 + 8 * h) * 2);
        vf[4 * s2 + 1] = *(const LAS bf16x8*)(vbuf + (32 + r) * 144 + (s2 * 16 + 8 * h) * 2);
        vf[4 * s2 + 2] = *(const LAS bf16x8*)(vbuf + r * 144 + (32 + s2 * 16 + 8 * h) * 2);
        vf[4 * s2 + 3] = *(const LAS bf16x8*)(vbuf + (32 + r) * 144 + (32 + s2 * 16 + 8 * h) * 2);
    }
    __builtin_amdgcn_sched_barrier(0);
    float rs = 0.f;
    if (MASK != 0) {
        const int lo = (MASK == 2) ? tq - 511 : -(1 << 30);
#pragma unroll
        for (int reg = 0; reg < 16; ++reg) {
            const int kp0 = kt * 64 + crow(reg, h), kp1 = kp0 + 32;
            s0[reg] = (kp0 <= tq && kp0 >= lo) ? s0[reg] : NEGINF; s1[reg] = (kp1 <= tq && kp1 >= lo) ? s1[reg] : NEGINF;
        }
    }
#pragma unroll
    for (int reg = 0; reg < 16; ++reg) { s0[reg] = ex2(s0[reg]); s1[reg] = ex2(s1[reg]); rs += s0[reg] + s1[reg]; }
    l += rs;
#pragma unroll
    for (int s2 = 0; s2 < 2; ++s2) {
        const bf16x8 p0 = pack8(s0, s2), p1 = pack8(s1, s2);
        o0 = MFMA32(vf[4 * s2 + 0], p0, o0);
        o1 = MFMA32(vf[4 * s2 + 1], p0, o1);
        o0 = MFMA32(vf[4 * s2 + 2], p1, o0);
        o1 = MFMA32(vf[4 * s2 + 3], p1, o1);
    }
}
template <int MODE>
DI void nsa_branch(LAS unsigned char* lds, unsigned list, const bf16* kbase, const bf16* vbase, const bf16x8 (&qf)[4], const bf16x8 (&ka)[2], unsigned slope_pk,
                   int tile, int tq, unsigned sel, float slope2, float gate, int r, int h, int tid, LAS float* otl, const bool dry) {
#ifndef PROBE_NSA_MODE
#define PROBE_NSA_MODE 0
#endif
    const bool nocomp = dry && PROBE_NSA_MODE == 1, nostage = dry && PROBE_NSA_MODE == 2;
    const int srow = tid >> 3, sch = tid & 7;
    float l = 0.f; f32x16 o0 = zero16(), o1 = zero16();
    int buf = 0;
    {
        const int kt = __builtin_ctz(list);
        const u32x4 kx = *(const u32x4*)(kbase + (size_t)(kt * 64 + srow) * 64 + sch * 8);
        const u32x4 vx = *(const u32x4*)(vbase + (size_t)srow * 2048 + kt * 64 + sch * 8);
        *(LAS u32x4*)(lds + srow * 144 + sch * 16) = kx;
        *(LAS u32x4*)(lds + 18432 + srow * 144 + sch * 16) = vx;
    }
    __syncthreads();
    while (list) {
        const int kt = __builtin_ctz(list); list &= list - 1u;
        u32x4 kx, vx;
        if (list && !nostage) {
            const int nk = __builtin_ctz(list);
            kx = *(const u32x4*)(kbase + (size_t)(nk * 64 + srow) * 64 + sch * 8);
            vx = *(const u32x4*)(vbase + (size_t)srow * 2048 + nk * 64 + sch * 8);
        }
        const bool lanesel = (MODE == 1) ? (((sel >> kt) & 1u) != 0u) : true;
        const bool act = (MODE == 1) ? (__ballot(lanesel) != 0ull) : true;
        if (act && !nocomp) {
            const bf16x8 qa = aug_q(slope_pk, lanesel ? slope2 * (float)(kt * 64 - tq) : -30000.f, h);
            LAS unsigned char* kb_ = lds + buf * 9216; LAS unsigned char* vb_ = lds + 18432 + buf * 9216;
            const int mask = (kt == tile) ? 1 : ((MODE == 0 && kt == tile - 8) ? 2 : 0);
            nsa_tile(mask, kb_, vb_, qf, ka, qa, kt, tq, r, h, l, o0, o1);
        }
        if (list && !nostage) {
            *(LAS u32x4*)(lds + (buf ^ 1) * 9216 + srow * 144 + sch * 16) = kx;
            *(LAS u32x4*)(lds + 18432 + (buf ^ 1) * 9216 + srow * 144 + sch * 16) = vx;
        }
        __syncthreads();
        buf ^= 1;
    }
    const float lt = l + __shfl_xor(l, 32);
    const float sc = (lt > 0.f) ? gate / lt : 0.f;
#pragma unroll
    for (int reg = 0; reg < 16; ++reg) { otl[reg * 64] += sc * o0[reg]; otl[(16 + reg) * 64] += sc * o1[reg]; }
}

DI void nsa_unit(const Args& A, LAS unsigned char* lds, int b, int g, int tile, int tid, int lane, int wave, const bool dry) {
    unsigned char* ws = A.ws;
    LAS unsigned* UNI = (LAS unsigned*)(lds + 36864);
    const int r = lane & 31, h = lane >> 5;
    const int t0 = tile * 64, tq = t0 + wave * 8 + (r >> 2), hd = g * 4 + (r & 3);
    const float slope2 = ex2(-(float)(hd + 1)) * LOG2E;
    unsigned slope_pk; { const unsigned sh = (unsigned)f2bf(slope2); const unsigned sl = (unsigned)f2bf(slope2 - bf2f((unsigned short)sh)); slope_pk = sh | (sl << 16); }
    bf16x8 ka[2]; ka[0] = aug_k(r, h); ka[1] = aug_k(32 + r, h);
    const size_t tokrow = (size_t)(b * SEQ + tq);
    const size_t bg = (size_t)(b * 2 + g);
    const int srow = tid >> 3, sch = tid & 7;
    bf16x8 qf[4];
    {
        const bf16* qp = (const bf16*)(ws + WS_ZQ) + tokrow * 512 + hd * 64 + 8 * h;
        u32x4 raw[4]; float ss = 0.f;
#pragma unroll
        for (int j = 0; j < 4; ++j) { raw[j] = __builtin_nontemporal_load((const u32x4*)(qp + 16 * j));
#pragma unroll
            for (int e = 0; e < 4; ++e) { const float a = lo16(raw[j][e]), c = hi16(raw[j][e]); ss += a * a + c * c; } }
        ss += __shfl_xor(ss, 32);
        const float rstd = rsqrtf(ss * (1.f / 64.f) + EPS) * (0.125f * LOG2E);
#pragma unroll
        for (int j = 0; j < 4; ++j) { u32x4 y; const float* qg = A.qg + 16 * j + 8 * h;
#pragma unroll
            for (int e = 0; e < 4; ++e) y[e] = pk2(lo16(raw[j][e]) * rstd * qg[2 * e], hi16(raw[j][e]) * rstd * qg[2 * e + 1]);
            qf[j] = __builtin_bit_cast(bf16x8, y); }
    }
    const bf16* zg = (const bf16*)(ws + WS_ZG) + tokrow * 32 + hd * 3;
    const float gate_c = bf2f(zg[0]), gate_s = bf2f(zg[1]), gate_w = bf2f(zg[2]);
    LAS float* otl = (LAS float*)(lds + 40960 + wave * 8192) + lane;
    unsigned sel;
    {
        const bool two = tile >= 16;
        const bf16* kc = (const bf16*)(ws + WS_KC) + bg * 128 * 64; const bf16* vc = (const bf16*)(ws + WS_VCT) + bg * 64 * 128;
        *(LAS u32x4*)(lds + srow * 144 + sch * 16) = *(const u32x4*)(kc + srow * 64 + sch * 8);
        *(LAS u32x4*)(lds + 18432 + srow * 144 + sch * 16) = *(const u32x4*)(vc + srow * 128 + sch * 8);
        if (two) {
            *(LAS u32x4*)(lds + 9216 + srow * 144 + sch * 16) = *(const u32x4*)(kc + 64 * 64 + srow * 64 + sch * 8);
            *(LAS u32x4*)(lds + 18432 + 9216 + srow * 144 + sch * 16) = *(const u32x4*)(vc + srow * 128 + 64 + sch * 8);
        }
        __syncthreads();
        f32x16 sc[4];
        float lsum = 0.f;
#pragma unroll
        for (int idx = 0; idx < 4; ++idx) {
            const int kt = idx >> 1, kb = idx & 1;
            f32x16 s = zero16();
            if (kt == 0 || two) {
#pragma unroll
                for (int j = 0; j < 4; ++j) s = MFMA32(*(const LAS bf16x8*)(lds + kt * 9216 + (kb * 32 + r) * 144 + (16 * j + 8 * h) * 2), qf[j], s);
                s = MFMA32(aug_k(16 * (kb * 32 + r), h), aug_q(slope_pk, slope2 * (float)(1024 * kt + 31 - tq), h), s);
            }
#pragma unroll
            for (int reg = 0; reg < 16; ++reg) {
                const int n = idx * 32 + crow(reg, h), ce = 16 * n + 31;
                const bool v = (ce <= tq) && (kt == 0 || two);
                const float p = ex2(v ? s[reg] : NEGINF);
                s[reg] = p; lsum += p;
            }
            sc[idx] = s;
        }
        lsum += __shfl_xor(lsum, 32);
        const float inv = (lsum > 0.f) ? 1.f / lsum : 0.f;
        {
            f32x16 o0 = zero16(), o1 = zero16();
#pragma unroll
            for (int idx = 0; idx < 4; ++idx) {
                const int kt = idx >> 1, kb = idx & 1;
                if (kt == 0 || two) {
#pragma unroll
                    for (int s2 = 0; s2 < 2; ++s2) {
                        const bf16x8 pf = pack8(sc[idx], s2);
                        o0 = MFMA32(*(const LAS bf16x8*)(lds + 18432 + kt * 9216 + r * 144 + (kb * 32 + s2 * 16 + 8 * h) * 2), pf, o0);
                        o1 = MFMA32(*(const LAS bf16x8*)(lds + 18432 + kt * 9216 + (32 + r) * 144 + (kb * 32 + s2 * 16 + 8 * h) * 2), pf, o1);
                    }
                }
            }
            const float scl = gate_c * inv;
#pragma unroll
            for (int reg = 0; reg < 16; ++reg) { otl[reg * 64] = scl * o0[reg]; otl[(16 + reg) * 64] = scl * o1[reg]; }
        }
        float own4[16], last[16];
#pragma unroll
        for (int G = 0; G < 16; ++G) {
            const f32x16& sv = sc[G >> 2]; const int b4 = 4 * (G & 3);
            float a = ((sv[b4] + sv[b4 + 1]) + (sv[b4 + 2] + sv[b4 + 3])) * inv, c = sv[b4 + 3] * inv;
            a += dpp_xor1(a); a += dpp_xor2(a); c += dpp_xor1(c); c += dpp_xor2(c);
            own4[G] = a; last[G] = c;
        }
        float impE[16], impO[16];
        {
            float plast[16], impown[16];
#pragma unroll
            for (int G = 0; G < 16; ++G) plast[G] = __shfl_xor(last[G], 32);
#pragma unroll
            for (int G = 0; G < 16; ++G) { const float prev = h ? plast[G] : (G > 0 ? plast[G > 0 ? G - 1 : 0] : 0.f); impown[G] = own4[G] + prev; }
#pragma unroll
            for (int G = 0; G < 16; ++G) { const float oth = __shfl_xor(impown[G], 32); impE[G] = h ? oth : impown[G]; impO[G] = h ? impown[G] : oth; }
        }
        const int cur = tq >> 6;
        sel = 1u | (1u << cur) | (cur > 0 ? (1u << (cur - 1)) : 0u);
        const int nslots = 8 - __popc(sel);
        unsigned key[30];
#pragma unroll
        for (int j = 1; j < 30; ++j) {
            const float v = (j & 1) ? impO[j >> 1] : impE[j >> 1];
            key[j] = (j <= cur - 2) ? ((__float_as_uint(v) & ~31u) | (unsigned)(31 - j)) : 0u;
        }
        unsigned prevk = 0xffffffffu;
#pragma unroll 1
        for (int it = 0; it < 5; ++it) {
            if (it < nslots) {
                unsigned mk = 0u;
#pragma unroll
                for (int j = 1; j < 30; ++j) { const unsigned kk = (key[j] < prevk) ? key[j] : 0u; mk = mk > kk ? mk : kk; }
                if (mk != 0u) sel |= 1u << (31u - (mk & 31u));
                prevk = mk;
            }
        }
        unsigned wm = sel;
#pragma unroll
        for (int o = 1; o < 64; o <<= 1) wm |= (unsigned)__shfl_xor((int)wm, o);
        if (lane == 0) UNI[wave] = wm;
        __syncthreads();
    }
    unsigned uni = 0u;
#pragma unroll
    for (int w = 0; w < 8; ++w) uni |= UNI[w];
    uni = (unsigned)__builtin_amdgcn_readfirstlane((int)uni);
    if (!(dry && PROBE_NSA_MODE == 3)) {
    {
        const int lo = tile > 8 ? tile - 8 : 0;
        const unsigned wl = ((2u << tile) - 1u) & ~((1u << lo) - 1u);
        const size_t slab = (size_t)((1 * 8 + b) * 2 + g);
        nsa_branch<0>(lds, wl, (const bf16*)(ws + WS_KN) + slab * 2048 * 64, (const bf16*)(ws + WS_VT) + slab * 64 * 2048, qf, ka, slope_pk, tile, tq, sel, slope2, gate_w, r, h, tid, otl, dry);
    }
    {
        const size_t slab = (size_t)((0 * 8 + b) * 2 + g);
        nsa_branch<1>(lds, uni, (const bf16*)(ws + WS_KN) + slab * 2048 * 64, (const bf16*)(ws + WS_VT) + slab * 64 * 2048, qf, ka, slope_pk, tile, tq, sel, slope2, gate_s, r, h, tid, otl, dry);
    }
    }
    bf16* yp = (bf16*)(ws + WS_Y) + tokrow * 1024 + hd * 64 + 4 * h;
#pragma unroll
    for (int g4 = 0; g4 < 4; ++g4) {
        u32x2 w0, w1;
        w0.x = pk2(otl[(4 * g4) * 64], otl[(4 * g4 + 1) * 64]); w0.y = pk2(otl[(4 * g4 + 2) * 64], otl[(4 * g4 + 3) * 64]);
        w1.x = pk2(otl[(16 + 4 * g4) * 64], otl[(16 + 4 * g4 + 1) * 64]); w1.y = pk2(otl[(16 + 4 * g4 + 2) * 64], otl[(16 + 4 * g4 + 3) * 64]);
        if (!dry) { *(u32x2*)(yp + 8 * g4) = w0; *(u32x2*)(yp + 32 + 8 * g4) = w1; }
    }
}

DI int next_unit(unsigned* ctr, LAS unsigned char* lds, int tid) {
    volatile LAS int* slot = (volatile LAS int*)(lds + 131072 + 128);
    __syncthreads();
    if (tid == 0) *slot = (int)__hip_atomic_fetch_add(ctr, 1u, __ATOMIC_RELAXED, __HIP_MEMORY_SCOPE_AGENT);
    __syncthreads();
    return *slot;
}
__global__ void __launch_bounds__(512, 2) hybrid_fwd(Args A) {
    extern __shared__ __attribute__((aligned(16))) unsigned char lds_raw[];
    LAS unsigned char* lds = (LAS unsigned char*)lds_raw;
    const int wave = __builtin_amdgcn_readfirstlane((int)(threadIdx.x >> 6));
#define lane xb_lane()
#define tid (wave * 64 + xb_lane())
    const int G = gridDim.x, bid = blockIdx.x;
    unsigned char* ws = A.ws;
    const int lo = A.ph_lo, hi = A.ph_hi;
#ifndef PH_ONLY
#define PH_ONLY -1
#endif
#ifndef PROBE_REP
#define PROBE_REP -1
#endif
#define IN(k) ((PH_ONLY < 0 || PH_ONLY == (k)) && lo <= (k) && (k) < hi)
#define SEAM(k) do { if (IN(k) && IN((k) + 1)) { if (A.coop == 1) xcd_barrier(bar); } } while (0)
    {
        volatile LAS unsigned* st = (volatile LAS unsigned*)(lds + 131072 + 64);
        if (tid < 2) st[tid] = 0u;
        __syncthreads();
    }
    if (A.coop == 2) cg::this_grid().sync();
    XcdBarrier bar; bar.bar = (unsigned*)(ws + WS_BAR); bar.x = 0; bar.st = (volatile LAS unsigned*)(lds + 131072 + 64); bar.wave = wave;
    if (A.coop == 1) bar = xcd_barrier_post((unsigned*)(ws + WS_BAR), (volatile LAS unsigned*)(lds + 131072 + 64), wave);
    if (IN(0)) { phase0(A, lds, tid, lane, wave, 0, bid * 8 + wave, G * 8); __syncthreads(); }
    SEAM(0);
    if (PROBE_REP == 100) { for (int i = 0; i < 10; ++i) xcd_barrier(bar); }
    if (IN(1)) {
        pg8::Gemm g{(const bf16*)(ws + WS_H), (const bf16*)(ws + WS_WIN), M, NINP, DM, wave}; pg8::StaticOrder S; S.init(M, NINP, G, bid);
        EpiZ E{ws};
        if (PROBE_REP == 1) { pg8::gemm_phase<EpiZ, pg8::StaticOrder, true, true>(lds, g, S, E); xcd_barrier(bar); }
        pg8::gemm_phase<EpiZ, pg8::StaticOrder, true, true>(lds, g, S, E);
        { const int nfull = (M / 256) * (NINP / 256) % G;
          if (nfull == 0) phase0(A, lds, tid, lane, wave, 1, bid * 8 + wave, G * 8);
          else if (bid >= nfull) phase0(A, lds, tid, lane, wave, 1, (bid - nfull) * 8 + wave, (G - nfull) * 8);
          __syncthreads(); }
    }
    SEAM(1);
    if (IN(2)) {
        if (PROBE_REP >= 21 && PROBE_REP <= 23) {
            unsigned* ctr0 = (unsigned*)(ws + WS_BAR) + 3664;
            const int nun = PROBE_REP == 21 ? 128 : (PROBE_REP == 22 ? 512 : 256);
            for (;;) {
                const int u = next_unit(ctr0, lds, tid);
                if (u >= nun) break;
                if (PROBE_REP == 21) compress_unit(A, lds, u, tid, lane, wave);
                else if (PROBE_REP == 22) { if (u < 128) rstate_group(A, lds, u, tid, lane, wave); }
                else kvprep_unit(A, lds, u, lane, wave);
            }
            xcd_barrier(bar);
        }
        for (int rep = (PROBE_REP == 2 ? 0 : 1); rep < 2; ++rep) {
        if (PROBE_REP == 2 && rep == 1) xcd_barrier(bar);
        unsigned* ctr = (unsigned*)(ws + WS_BAR) + 3600 + 32 * rep;
        if (G == 256) {
            if (bid < 128) compress_unit(A, lds, bid, tid, lane, wave);
            else rstate_group(A, lds, bid - 128, tid, lane, wave);
            kvprep_unit(A, lds, bid, lane, wave);
        } else
        for (;;) {
            const int u = next_unit(ctr, lds, tid);
            if (u >= 512) break;
            if (u < 128) compress_unit(A, lds, u, tid, lane, wave);
            else if (u < 256) rstate_group(A, lds, u - 128, tid, lane, wave);
            else kvprep_unit(A, lds, u - 256, lane, wave);
        } }
    }
    SEAM(2);
    if (IN(3)) {
#define PH3_NSA(DRY, CTR) do { \
        unsigned* ctr = (unsigned*)(ws + WS_BAR) + (CTR); \
        for (;;) { \
            const int u = next_unit(ctr, lds, tid); \
            if (u >= 512) break; \
            nsa_unit(A, lds, (u & 15) >> 1, u & 1, 31 - (u >> 4), tid, lane, wave, DRY); \
        } } while (0)
#define PH3_ROUT(DRY, CTR) do { \
        unsigned* ctr = (unsigned*)(ws + WS_BAR) + (CTR); \
        for (;;) { \
            const int u = next_unit(ctr, lds, tid); \
            if (u >= 512) break; \
            rout_unit(A, lds, u, tid, lane, wave, DRY); \
        } } while (0)
        if (PROBE_REP == 31) { PH3_NSA(true, 3856); xcd_barrier(bar); }
        if (PROBE_REP == 32) { PH3_ROUT(true, 3888); xcd_barrier(bar); }
        if (G == 256) {
            const int b3 = bid & 7, k3 = bid >> 3;
            nsa_unit(A, lds, b3, k3 & 1, 31 - (k3 >> 1), tid, lane, wave, false); __syncthreads();
            nsa_unit(A, lds, b3, k3 & 1, k3 >> 1, tid, lane, wave, false); __syncthreads();
            rout_unit(A, lds, b3 * 64 + k3 * 2, tid, lane, wave, false);
            rout_unit(A, lds, b3 * 64 + k3 * 2 + 1, tid, lane, wave, false);
        } else {
        PH3_NSA(false, 3792);
        PH3_ROUT(false, 3824);
        }
    }
    SEAM(3);
    if (IN(4)) {
        pg8::Gemm g{(const bf16*)(ws + WS_Y), (const bf16*)(ws + WS_WB), M, DM, DM, wave}; pg8::StaticOrder S; S.init(M, DM, G, bid);
        EpiMix E{(const bf16*)(ws + WS_ZM), (bf16*)(ws + WS_MIX)};
        if (PROBE_REP == 4) { pg8::gemm_phase<EpiMix, pg8::StaticOrder, true, true>(lds, g, S, E); xcd_barrier(bar); }
        pg8::gemm_phase<EpiMix, pg8::StaticOrder, true, true>(lds, g, S, E);
    }
    SEAM(4);
    if (IN(5)) {
        pg8::Gemm g{(const bf16*)(ws + WS_MIX), (const bf16*)(ws + WS_WO), M, DM, DM, wave}; pg8::StaticOrder S; S.init(M, DM, G, bid);
        EpiOut E{A.x, A.out, (bf16*)(ws + WS_X1B), (float*)(ws + WS_SSQ)};
        if (PROBE_REP == 5) { pg8::gemm_phase<EpiOut, pg8::StaticOrder, true, true>(lds, g, S, E); xcd_barrier(bar); }
        pg8::gemm_phase<EpiOut, pg8::StaticOrder, true, true>(lds, g, S, E);
    }
    SEAM(5);
    if (IN(6)) {
        pg8::Gemm g{(const bf16*)(ws + WS_X1B), (const bf16*)(ws + WS_WGU), M, NGU, DM, wave}; pg8::StaticOrder S; S.init(M, NGU, G, bid);
        pg8::Unit u0; u0.pm = -1; u0.pn = 0;
        {
            LAS float* tab = (LAS float*)(lds + 131072 + 1024);
            if (S.next(0, u0) && tid < 256) {
                const f32x4* sp = (const f32x4*)((const float*)(ws + WS_SSQ) + (size_t)(u0.pm * 256 + tid) * 16);
                const f32x4 s0 = sp[0], s1 = sp[1], s2 = sp[2], s3 = sp[3];
                const float tot = ((s0[0] + s0[1]) + (s0[2] + s0[3])) + ((s1[0] + s1[1]) + (s1[2] + s1[3])) + ((s2[0] + s2[1]) + (s2[2] + s2[3])) + ((s3[0] + s3[1]) + (s3[2] + s3[3]));
                tab[tid] = rsqrtf(tot * (1.f / 1024.f) + EPS);
            }
            __syncthreads();
        }
        EpiFfn E{(const LAS float*)(lds + 131072 + 1024), (bf16*)(ws + WS_HID), (const float*)(ws + WS_SSQ), u0.pm};
        if (PROBE_REP == 6) { pg8::gemm_phase<EpiFfn, pg8::StaticOrder, true, true>(lds, g, S, E); xcd_barrier(bar); }
        pg8::gemm_phase<EpiFfn, pg8::StaticOrder, true, true>(lds, g, S, E);
    }
    SEAM(6);
    if (IN(7)) {
        pg8::Gemm g{(const bf16*)(ws + WS_HID), (const bf16*)(ws + WS_WDN), M, DM, DFF, wave}; pg8::StaticOrder S; S.init(M, DM, G, bid);
        if (PROBE_REP == 7) { EpiDown E0{A.out, (const bf16*)(ws + WS_X1B), 1}; pg8::gemm_phase<EpiDown, pg8::StaticOrder, true, true>(lds, g, S, E0); xcd_barrier(bar); }
        EpiDown E{A.out, (const bf16*)(ws + WS_X1B), 0};
        pg8::gemm_phase<EpiDown, pg8::StaticOrder, true, true>(lds, g, S, E);
    }
#undef IN
#undef SEAM
#undef lane
#undef tid
}

extern "C" void kernel_launch(void* const* d_in, const int* in_sizes, int n_in, void* d_out, int out_size, void* d_ws, size_t ws_size, hipStream_t stream) {
    static int grid = 0;
    if (grid == 0) {
        if (n_in != 15 || in_sizes[0] != M * DM || out_size != M * DM || ws_size < WS_END) { fprintf(stderr, "kernel_launch: unexpected shapes (n_in %d, ws %zu)\n", n_in, ws_size); grid = -1; return; }
        int dev = 0, cus = 0, per_cu = 0;
        (void)hipGetDevice(&dev);
        (void)hipDeviceGetAttribute(&cus, hipDeviceAttributeMultiprocessorCount, dev);
        (void)hipFuncSetAttribute((const void*)hybrid_fwd, hipFuncAttributeMaxDynamicSharedMemorySize, LDS_BYTES);
        if (hipOccupancyMaxActiveBlocksPerMultiprocessor(&per_cu, (const void*)hybrid_fwd, 512, LDS_BYTES) != hipSuccess || per_cu < 1) per_cu = 1;
        (void)hipGetLastError();
        grid = cus * per_cu;
#ifdef PROBE_GRID
        grid = PROBE_GRID;
#endif
        if (grid < 1) grid = 256;
    }
    if (grid < 0) return;
    Args a{};
    a.x = (const float*)d_in[0]; a.n1g = (const float*)d_in[1]; a.win = (const float*)d_in[2]; a.qg = (const float*)d_in[3]; a.kg = (const float*)d_in[4];
    a.pe = (const float*)d_in[5]; a.w1 = (const float*)d_in[6]; a.w2 = (const float*)d_in[7]; a.gng = (const float*)d_in[8]; a.wb = (const float*)d_in[9];
    a.wo = (const float*)d_in[10]; a.n2g = (const float*)d_in[11]; a.wg = (const float*)d_in[12]; a.wu = (const float*)d_in[13]; a.wd = (const float*)d_in[14];
    a.out = (float*)d_out; a.ws = (unsigned char*)d_ws;
#if MK_SPLIT
    for (int p = 0; p < 8; ++p) {
        a.ph_lo = p; a.ph_hi = p + 1; a.coop = 0;
        hipLaunchKernelGGL(hybrid_fwd, dim3(grid), dim3(512), LDS_BYTES, stream, a);
    }
#else
    a.ph_lo = 0; a.ph_hi = 8; a.coop = 1;
    (void)hipMemsetAsync((unsigned char*)d_ws + WS_BAR, 0, BAR_BYTES, stream);
    void* args[] = {&a};
    hipError_t e = hipLaunchCooperativeKernel((const void*)hybrid_fwd, dim3(grid), dim3(512), args, LDS_BYTES, stream);
    if (e != hipSuccess) fprintf(stderr, "cooperative launch failed: %s (grid %d)\n", hipGetErrorString(e), grid);
#ifdef PROBE_TWICE
    (void)hipMemsetAsync((unsigned char*)d_ws + WS_BAR, 0, BAR_BYTES, stream);
    (void)hipLaunchCooperativeKernel((const void*)hybrid_fwd, dim3(grid), dim3(512), args, LDS_BYTES, stream);
#endif
#endif
}
```

```cpp
#include <hip/hip_runtime.h>
#include <hip/hip_cooperative_groups.h>
#include <cstdio>
#include <cstdint>
#include <cmath>
#ifndef PG8_WGM
#define PG8_WGM 8
#endif
namespace pg8 {
#define PG8_LAS __attribute__((address_space(3)))
typedef unsigned short bf16_t;
typedef short bf16x8 __attribute__((ext_vector_type(8)));
typedef float f32x4 __attribute__((ext_vector_type(4)));
typedef unsigned u32x4 __attribute__((ext_vector_type(4)));
constexpr int BM = 256, BK = 64, HALF = 128, HTB = HALF * BK * 2  , STAGE_BYTES = 8 * HTB, NXCD = 8, WGM = PG8_WGM;

__host__ __device__ __forceinline__ int lds_byte(int r, int c) { const int st = (r >> 4) * 2 + (c >> 5), rr = r & 15, cc = c & 31, ob = rr * 64 + cc * 2; return st * 1024 + (ob ^ (((ob >> 9) & 1) << 5)); }
__host__ __device__ __forceinline__ void stage_rc(int b, int& R, int& C) { const int st = b / 1024, sb = b % 1024, swz = sb ^ (((sb >> 9) & 1) << 5); R = (st >> 1) * 16 + swz / 64; C = (st & 1) * 32 + (swz % 64) / 2; }
__host__ __device__ __forceinline__ int perm32(int rho) { const int n = rho >> 4, i = rho & 15; return 8 * (i >> 2) + 4 * n + (i & 3); }

struct Unit { int pm, pn; };
struct Gemm { const bf16_t* A; const bf16_t* Bt; int M, N, K; int wid; };

struct StaticOrder {
    int nM, nN, nwg, G, c;
    __host__ __device__ __forceinline__ void init(int M, int N, int G_, int c_) { nM = M / BM; nN = N / BM; nwg = nM * nN; G = G_; c = c_; }
    __host__ __device__ __forceinline__ bool next(int i, Unit& u) const {
        const long L = (long)i * G + c; if (L >= nwg) return false;
        int wgid = (int)L; { const int q = nwg / NXCD, r = nwg % NXCD, xcd = wgid % NXCD, off = wgid / NXCD; wgid = (xcd < r ? xcd * (q + 1) : r * (q + 1) + (xcd - r) * q) + off; }
        const int nig = WGM * nN, gid = wgid / nig, fm = gid * WGM, gsz = (nM - fm) < WGM ? (nM - fm) : WGM;
        u.pm = fm + ((wgid % nig) % gsz); u.pn = (wgid % nig) / gsz; return true;
    }
    __device__ __forceinline__ void a_ready(const Unit&) const {}
    __device__ __forceinline__ void done(const Unit&) const {}
};

__device__ __forceinline__ unsigned cvt_pk_bf16(float lo, float hi) { unsigned r; asm volatile("v_cvt_pk_bf16_f32 %0, %1, %2" : "=v"(r) : "v"(lo), "v"(hi)); return r; }
template <class Epi, class Sched, bool ALIGN_EPI = false, bool SP2 = false>
__device__ __forceinline__ void gemm_phase(PG8_LAS unsigned char* lds, const Gemm g, const Sched& S, const Epi& E) {
    const int wid = g.wid, lane = (int)__builtin_amdgcn_mbcnt_hi(~0u, __builtin_amdgcn_mbcnt_lo(~0u, (unsigned)g.wid * 0u)), tid = wid * 64 + lane, wr = wid >> 2, wc = wid & 3, fr = lane & 15, fq = lane >> 4;
    const int K = g.K, nt = K / BK;
    unsigned voffA[2], voffB[2];
#pragma unroll
    for (int i = 0; i < 2; ++i) { int R, C; stage_rc(tid * 16 + i * 8192, R, C); const int Rb = Epi::PERM ? ((R & ~31) + perm32(R & 31)) : R;
        voffA[i] = (unsigned)(R * K + C) * 2u; voffB[i] = (unsigned)(Rb * K + C) * 2u; }
    const size_t kstep = (size_t)(BK * 2);
    const size_t hstep = (size_t)HALF * K * 2;
    const size_t tstep = 2 * hstep;
    const unsigned ldsw = (unsigned)wid * 1024u;
    const int aoff = lds_byte(wr * 64 + fr, fq * 8), boff = lds_byte(wc * 32 + fr, fq * 8);
#define PG8_SA(b, h) (((b) * 2 + (h)) * HTB)
#define PG8_SB(b, h) ((4 + (b) * 2 + (h)) * HTB)
#define PG8_STAGE(bufoff, gbase, voff) do { _Pragma("unroll") for (int _i = 0; _i < 2; ++_i) \
        __builtin_amdgcn_global_load_lds((const unsigned*)((const char*)(gbase) + (voff)[_i]), (PG8_LAS unsigned*)(lds + (bufoff) + ldsw + _i * 8192), 16, 0, 0); } while (0)
#define PG8_LDA(dst, b, h) do { _Pragma("unroll") for (int m = 0; m < 4; ++m) _Pragma("unroll") for (int k = 0; k < 2; ++k) dst[m][k] = *(const PG8_LAS bf16x8*)(lds + PG8_SA(b, h) + aoff + m * 2048 + k * 1024); } while (0)
#define PG8_LDB(dst, b, h) do { _Pragma("unroll") for (int n = 0; n < 2; ++n) _Pragma("unroll") for (int k = 0; k < 2; ++k) dst[n][k] = *(const PG8_LAS bf16x8*)(lds + PG8_SB(b, h) + boff + n * 2048 + k * 1024); } while (0)
#define PG8_MMA(ai, bj, At, Bt) do { __builtin_amdgcn_s_setprio(1); _Pragma("unroll") for (int m = 0; m < 4; ++m) _Pragma("unroll") for (int n = 0; n < 2; ++n) _Pragma("unroll") for (int k = 0; k < 2; ++k) \
        acc[ai][bj][m][n] = __builtin_amdgcn_mfma_f32_16x16x32_bf16(Bt[n][k], At[m][k], acc[ai][bj][m][n], 0, 0, 0); __builtin_amdgcn_s_setprio(0); } while (0)
#define PG8_WAIT_V(n) asm volatile("s_waitcnt vmcnt(" #n ")" ::: "memory")
#define PG8_WAIT_L(n) asm volatile("s_waitcnt lgkmcnt(" #n ")" ::: "memory")
#define PG8_BAR __builtin_amdgcn_s_barrier()
#define PG8_SCHED __builtin_amdgcn_sched_barrier(0)
    Unit cur, nxt; int ui = 0;
    if (!S.next(0, cur)) return;
    f32x4 acc[2][2][4][2];
#pragma unroll
    for (int a = 0; a < 2; ++a)
#pragma unroll
        for (int b = 0; b < 2; ++b)
#pragma unroll
            for (int m = 0; m < 4; ++m)
#pragma unroll
                for (int n = 0; n < 2; ++n) acc[a][b][m][n] = (f32x4){0.f, 0.f, 0.f, 0.f};
    bf16x8 At[4][2], B0[2][2], B1[2][2];
    const char* cA = (const char*)g.A + (size_t)cur.pm * tstep; const char* cB = (const char*)g.Bt + (size_t)cur.pn * tstep;
    S.a_ready(cur);
    if constexpr (SP2) {
        PG8_STAGE(PG8_SB(0, 0), cB, voffB); PG8_STAGE(PG8_SB(0, 1), cB + hstep, voffB); PG8_STAGE(PG8_SA(0, 0), cA, voffA); PG8_STAGE(PG8_SA(0, 1), cA + hstep, voffA);
        if (wr == 1) PG8_BAR;
        PG8_WAIT_V(2); PG8_BAR;
        PG8_STAGE(PG8_SB(1, 0), cB + kstep, voffB); PG8_STAGE(PG8_SA(1, 0), cA + kstep, voffA); PG8_STAGE(PG8_SB(1, 1), cB + hstep + kstep, voffB);
        PG8_WAIT_V(6); PG8_BAR;
    } else {
        PG8_STAGE(PG8_SB(0, 0), cB, voffB); PG8_STAGE(PG8_SA(0, 0), cA, voffA); PG8_STAGE(PG8_SB(0, 1), cB + hstep, voffB); PG8_STAGE(PG8_SA(0, 1), cA + hstep, voffA);
        if (wr == 1) PG8_BAR;
        PG8_WAIT_V(4); PG8_BAR;
        PG8_STAGE(PG8_SB(1, 0), cB + kstep, voffB); PG8_STAGE(PG8_SA(1, 0), cA + kstep, voffA); PG8_STAGE(PG8_SB(1, 1), cB + hstep + kstep, voffB);
        PG8_WAIT_V(6); PG8_BAR;
    }
    for (;;) {
        const bool has_next = S.next(ui + 1, nxt);
        const char* nA = has_next ? (const char*)g.A + (size_t)nxt.pm * tstep : cA; const char* nB = has_next ? (const char*)g.Bt + (size_t)nxt.pn * tstep : cB;
        for (int t = 0; t < nt; t += 2) {
            if constexpr (Epi::HAS_MID) { if (t == nt / 2) E.mid(acc, cur, wr, wc, fr, fq); }
            const bool last = (t == nt - 2);
            const char* a1 = cA + (size_t)(t + 1) * kstep;
            const char* a2 = last ? nA : cA + (size_t)(t + 2) * kstep; const char* b2 = last ? nB : cB + (size_t)(t + 2) * kstep;
            const char* a3 = a2 + kstep; const char* b3 = b2 + kstep;
            if (last && has_next) S.a_ready(nxt);
            if constexpr (SP2) {
            PG8_LDB(B0, 0, 0); PG8_LDB(B1, 0, 1); PG8_SCHED; PG8_LDA(At, 0, 0); PG8_STAGE(PG8_SA(1, 1), a1 + hstep, voffA);
            PG8_WAIT_V(8); PG8_WAIT_L(0); PG8_BAR; PG8_MMA(0, 0, At, B0); PG8_MMA(0, 1, At, B1); PG8_BAR; PG8_SCHED;
            PG8_LDA(At, 0, 1); PG8_STAGE(PG8_SB(0, 0), b2, voffB); PG8_STAGE(PG8_SB(0, 1), b2 + hstep, voffB); PG8_STAGE(PG8_SA(0, 0), a2, voffA);
            PG8_WAIT_V(8); PG8_WAIT_L(0); PG8_BAR; PG8_MMA(1, 0, At, B0); PG8_MMA(1, 1, At, B1); PG8_BAR; PG8_SCHED;
            PG8_LDB(B0, 1, 0); PG8_LDB(B1, 1, 1); PG8_SCHED; PG8_LDA(At, 1, 0); PG8_STAGE(PG8_SA(0, 1), a2 + hstep, voffA);
            PG8_WAIT_V(8); PG8_WAIT_L(0); PG8_BAR; PG8_MMA(0, 0, At, B0); PG8_MMA(0, 1, At, B1); PG8_BAR; PG8_SCHED;
            PG8_LDA(At, 1, 1); PG8_STAGE(PG8_SB(1, 0), b3, voffB); PG8_STAGE(PG8_SB(1, 1), b3 + hstep, voffB); PG8_STAGE(PG8_SA(1, 0), a3, voffA);
            PG8_WAIT_V(8); PG8_WAIT_L(0); PG8_BAR; PG8_MMA(1, 0, At, B0); PG8_MMA(1, 1, At, B1); PG8_BAR; PG8_SCHED;
            } else {
            PG8_LDB(B0, 0, 0); PG8_SCHED; PG8_LDA(At, 0, 0); PG8_STAGE(PG8_SA(1, 1), a1 + hstep, voffA);
            PG8_WAIT_L(8); PG8_BAR; PG8_WAIT_L(0); PG8_MMA(0, 0, At, B0); PG8_BAR; PG8_SCHED;
            PG8_LDB(B1, 0, 1); PG8_STAGE(PG8_SB(0, 0), b2, voffB);
            PG8_BAR; PG8_WAIT_L(0); PG8_MMA(0, 1, At, B1); PG8_BAR;
            PG8_LDA(At, 0, 1); PG8_STAGE(PG8_SA(0, 0), a2, voffA);
            PG8_BAR; PG8_WAIT_L(0); PG8_MMA(1, 0, At, B0); PG8_BAR; PG8_SCHED;
            PG8_STAGE(PG8_SB(0, 1), b2 + hstep, voffB);
            PG8_WAIT_V(6); PG8_BAR; PG8_MMA(1, 1, At, B1); PG8_BAR;
            PG8_LDB(B0, 1, 0); PG8_SCHED; PG8_LDA(At, 1, 0); PG8_STAGE(PG8_SA(0, 1), a2 + hstep, voffA);
            PG8_WAIT_L(8); PG8_BAR; PG8_WAIT_L(0); PG8_MMA(0, 0, At, B0); PG8_BAR; PG8_SCHED;
            PG8_LDB(B1, 1, 1); PG8_STAGE(PG8_SB(1, 0), b3, voffB);
            PG8_BAR; PG8_WAIT_L(0); PG8_MMA(0, 1, At, B1); PG8_BAR;
            PG8_LDA(At, 1, 1); PG8_STAGE(PG8_SA(1, 0), a3, voffA);
            PG8_BAR; PG8_WAIT_L(0); PG8_MMA(1, 0, At, B0); PG8_BAR; PG8_SCHED;
            PG8_STAGE(PG8_SB(1, 1), b3 + hstep, voffB);
            PG8_WAIT_V(6); PG8_BAR; PG8_MMA(1, 1, At, B1); PG8_BAR;
            }
        }
        if constexpr (ALIGN_EPI) { if (wr == 0) PG8_BAR; }
        if constexpr (!Epi::AFTER_DRAIN) { E(acc, cur, wr, wc, fr, fq); S.done(cur); }
        if (!has_next) break;
#pragma unroll
        for (int a = 0; a < 2; ++a)
#pragma unroll
            for (int b = 0; b < 2; ++b)
#pragma unroll
                for (int m = 0; m < 4; ++m)
#pragma unroll
                    for (int n = 0; n < 2; ++n) acc[a][b][m][n] = (f32x4){0.f, 0.f, 0.f, 0.f};
        cur = nxt; cA = nA; cB = nB; ++ui;
        if constexpr (ALIGN_EPI) { if (wr == 1) PG8_BAR; }
    }
    PG8_WAIT_V(0);
    if constexpr (!ALIGN_EPI) { if (wr == 0) PG8_BAR; }
    PG8_BAR;
    if constexpr (Epi::AFTER_DRAIN) { E.fused(acc, cur, wr, wc, fr, fq, lds, wid, lane); S.done(cur); }
#undef PG8_SA
#undef PG8_SB
#undef PG8_STAGE
#undef PG8_LDA
#undef PG8_LDB
#undef PG8_MMA
#undef PG8_WAIT_V
#undef PG8_WAIT_L
#undef PG8_BAR
#undef PG8_SCHED
}
}

namespace cg = cooperative_groups;
#ifndef MK_SPLIT
#define MK_SPLIT 0
#endif
#define DI __device__ __forceinline__
#define LAS __attribute__((address_space(3)))
typedef unsigned short bf16;
typedef short bf16x8 __attribute__((ext_vector_type(8)));
typedef float f32x4 __attribute__((ext_vector_type(4)));
typedef float f32x16 __attribute__((ext_vector_type(16)));
typedef unsigned u32x4 __attribute__((ext_vector_type(4)));
typedef unsigned u32x2 __attribute__((ext_vector_type(2)));
typedef float f32x2_t __attribute__((ext_vector_type(2)));
typedef __bf16 bf16x2_t __attribute__((ext_vector_type(2)));
#define LDS_WAIT() asm volatile("s_waitcnt lgkmcnt(0)" ::: "memory")
#define MFMA32(a, b, c) __builtin_amdgcn_mfma_f32_32x32x16_bf16((a), (b), (c), 0, 0, 0)

constexpr int BATCH = 8, SEQ = 2048, DM = 1024, M = BATCH * SEQ;
constexpr int NIN = 5400, NINP = 5632, DFF = 2816, NGU = 5632;
constexpr float EPS = 1e-6f, LOG2E = 1.4426950408889634f;
constexpr float NEGINF = -__builtin_huge_valf();

constexpr size_t MiB = 1u << 20;
constexpr size_t WS_BIASP = 0;
constexpr size_t WS_W2T = 64 * 1024;
constexpr size_t WS_BAR = 512 * 1024, BAR_BYTES = 16384;
constexpr size_t WS_SSQ = 1 * MiB;
constexpr size_t WS_WIN = 2 * MiB;
constexpr size_t WS_WGU = 13 * MiB;
constexpr size_t WS_WDN = 24 * MiB;
constexpr size_t WS_WB = 30 * MiB;
constexpr size_t WS_WO = 32 * MiB;
constexpr size_t WS_W1T = 34 * MiB;
constexpr size_t WS_KC = 35 * MiB;
constexpr size_t WS_VCT = 35 * MiB + 512 * 1024;
constexpr size_t WS_ZG = 36 * MiB;
constexpr size_t WS_RK = 37 * MiB, WS_RV = 53 * MiB;
constexpr size_t WS_X1B = 37 * MiB;
constexpr size_t WS_ZM = 69 * MiB;
constexpr size_t WS_ZQ = 133 * MiB;
constexpr size_t WS_ZKV = 181 * MiB;
constexpr size_t WS_HID = 69 * MiB;
constexpr size_t WS_RQ = 149 * MiB, WS_RG = 165 * MiB;
constexpr size_t WS_Y = 181 * MiB;
constexpr size_t WS_H = 205 * MiB;
constexpr size_t WS_KVT = 221 * MiB;
constexpr size_t WS_MIX = 133 * MiB;
constexpr size_t WS_KN = 237 * MiB;
constexpr size_t WS_VT = 245 * MiB;
constexpr size_t WS_END = 253 * MiB;
constexpr int LDS_BYTES = 147456;

struct Args {
    const float* x; const float* n1g; const float* win; const float* qg; const float* kg; const float* pe; const float* w1; const float* w2;
    const float* gng; const float* wb; const float* wo; const float* n2g; const float* wg; const float* wu; const float* wd;
    float* out; unsigned char* ws; int ph_lo, ph_hi, coop, pad;
};

DI float bf2f(unsigned short b) { return __uint_as_float((unsigned)b << 16); }
DI unsigned pk2(float lo, float hi) { f32x2_t v = {lo, hi}; bf16x2_t b = __builtin_convertvector(v, bf16x2_t); return __builtin_bit_cast(unsigned, b); }
DI unsigned short f2bf(float f) { return (unsigned short)(pk2(f, 0.f) & 0xffffu); }
DI float lo16(unsigned w) { return __uint_as_float(w << 16); }
DI float hi16(unsigned w) { return __uint_as_float(w & 0xffff0000u); }
DI float ex2(float x) { return __builtin_amdgcn_exp2f(x); }
DI float sigm(float x) { return __builtin_amdgcn_rcpf(1.f + ex2(-x * LOG2E)); }
DI int crow(int reg, int h) { return (reg & 3) + 8 * (reg >> 2) + 4 * h; }
DI int perm16(int k) { return ((k >> 2) & 1) * 8 + (k >> 3) * 4 + (k & 3); }
DI float wave_sum(float v) {
#pragma unroll
    for (int o = 1; o < 64; o <<= 1) v += __shfl_xor(v, o);
    return v;
}
DI float dpp_xor1(float v) { return __uint_as_float((unsigned)__builtin_amdgcn_update_dpp(0, (int)__float_as_uint(v), 0xB1, 0xF, 0xF, true)); }
DI float dpp_xor2(float v) { return __uint_as_float((unsigned)__builtin_amdgcn_update_dpp(0, (int)__float_as_uint(v), 0x4E, 0xF, 0xF, true)); }
DI bf16x8 pack8(const f32x16& x, int s) {
    u32x4 p; p.x = pk2(x[8 * s], x[8 * s + 1]); p.y = pk2(x[8 * s + 2], x[8 * s + 3]); p.z = pk2(x[8 * s + 4], x[8 * s + 5]); p.w = pk2(x[8 * s + 6], x[8 * s + 7]);
    return __builtin_bit_cast(bf16x8, p);
}
DI f32x16 zero16() { f32x16 z;
#pragma unroll
    for (int i = 0; i < 16; ++i) z[i] = 0.f;
    return z; }

#define XB_TMO      128
#define XB_XCNT(j)  (256  + 64 * (j))
#define XB_XSUB(j)  (1280 + 64 * (j))
#define XB_XGEN(j)  (2304 + 64 * (j))
#define XB_TOP      3328
#define XB_TOPGEN   3392
#define XCD_BAR_WORDS 3456
#define XB_SPIN_CAP (1u << 18)

__device__ __forceinline__ unsigned xb_ld(unsigned* p)              { return __hip_atomic_load(p, __ATOMIC_RELAXED, __HIP_MEMORY_SCOPE_AGENT); }
__device__ __forceinline__ unsigned xb_add(unsigned* p, unsigned v) { return __hip_atomic_fetch_add(p, v, __ATOMIC_RELAXED, __HIP_MEMORY_SCOPE_AGENT); }
__device__ __forceinline__ unsigned xb_xcc_id() { return (unsigned)__builtin_amdgcn_s_getreg((3 << 11) | 20) & 0xFu; }
#define XB_SPIN(cond, bar) do { unsigned _sp = 0; while (cond) { __builtin_amdgcn_s_sleep(1); \
    if ((++_sp & 255u) == 0u) { if (xb_ld(&(bar)[XB_TMO])) break; if (_sp > XB_SPIN_CAP) { atomicAdd(&(bar)[XB_TMO], 1u); break; } } } } while (0)

__device__ __forceinline__ int xb_lane() { int r; asm volatile("v_mbcnt_lo_u32_b32 %0, -1, 0\n\tv_mbcnt_hi_u32_b32 %0, -1, %0" : "=v"(r)); return r; }
struct XcdBarrier {
    unsigned* bar; unsigned x; int wave;
    volatile LAS unsigned* st;
};

__device__ __forceinline__ XcdBarrier xcd_barrier_post(unsigned* bar, volatile LAS unsigned* st, int wave) {
    XcdBarrier b; b.bar = bar; b.x = xb_xcc_id(); b.st = st; b.wave = wave;
    if (wave == 0 && xb_lane() == 0) (void)xb_add(&bar[XB_XCNT(b.x)], 1u);
    return b;
}
__device__ __forceinline__ void xcd_barrier_complete(unsigned* bar, unsigned x, unsigned& nloc, unsigned& nx) {
    const unsigned G = gridDim.x * gridDim.y * gridDim.z;
    unsigned sum, cnt, mine, sp = 0u;
    for (;;) {
        sum = 0u; cnt = 0u; mine = 0u;
#pragma unroll
        for (unsigned j = 0; j < 16; ++j) { const unsigned c = xb_ld(&bar[XB_XCNT(j)]); sum += c; cnt += (c > 0u) ? 1u : 0u; mine = (j == x) ? c : mine; }
        if (sum == G) break;
        __builtin_amdgcn_s_sleep(1);
        if ((++sp & 255u) == 0u) { if (xb_ld(&bar[XB_TMO])) break; if (sp > XB_SPIN_CAP) { atomicAdd(&bar[XB_TMO], 1u); break; } }
    }
    nloc = mine > 0u ? mine : 1u; nx = cnt > 0u ? cnt : 1u;
}

__device__ __forceinline__ void xcd_barrier(const XcdBarrier& b) {
    asm volatile("s_waitcnt vmcnt(0)" ::: "memory");
    __syncthreads();
    if (b.wave == 0 && xb_lane() == 0) {
        unsigned* bar = b.bar;
        __builtin_amdgcn_s_waitcnt(0);
        unsigned nloc = b.st[0], nx = b.st[1];
        if (nloc == 0u) { xcd_barrier_complete(bar, b.x, nloc, nx); b.st[0] = nloc; b.st[1] = nx; }
        const unsigned old = xb_add(&bar[XB_XSUB(b.x)], 1u);
        const unsigned gen = old / nloc;
        if (old + 1u == (gen + 1u) * nloc) {
            __builtin_amdgcn_fence(__ATOMIC_RELEASE, "agent");
            asm volatile("s_waitcnt vmcnt(0)" ::: "memory");
            const unsigned og = xb_add(&bar[XB_TOP], 1u);
            const unsigned tg = og / nx;
            if (og + 1u == (tg + 1u) * nx) xb_add(&bar[XB_TOPGEN], 1u);
            else XB_SPIN(xb_ld(&bar[XB_TOPGEN]) == tg, bar);
            __builtin_amdgcn_fence(__ATOMIC_ACQUIRE, "agent");
            xb_add(&bar[XB_XGEN(b.x)], 1u);
            asm volatile("s_waitcnt vmcnt(0)" ::: "memory");
        } else {
            XB_SPIN(xb_ld(&bar[XB_XGEN(b.x)]) == gen, bar);
            __builtin_amdgcn_fence(__ATOMIC_ACQUIRE, "agent");
            asm volatile("s_waitcnt vmcnt(0)" ::: "memory");
        }
    }
    __syncthreads();
}

struct EpiZ {
    static constexpr bool PERM = true, AFTER_DRAIN = false, HAS_MID = false;
    unsigned char* ws;
    DI void operator()(const f32x4 (&acc)[2][2][4][2], const pg8::Unit& u, int wr, int wc, int fr, int fq) const {
        const int pn = u.pn; bf16* base; int ld, c0; bool sig = false, narrow = false;
        if (pn < 2) { base = (bf16*)(ws + WS_ZQ); ld = 512; c0 = pn * 256; }
        else if (pn < 5) { base = (bf16*)(ws + WS_ZKV); ld = 768; c0 = (pn - 2) * 256; }
        else if (pn < 7) { base = (bf16*)(ws + WS_RQ); ld = 512; c0 = (pn - 5) * 256; }
        else if (pn < 9) { base = (bf16*)(ws + WS_RK); ld = 512; c0 = (pn - 7) * 256; }
        else if (pn < 11) { base = (bf16*)(ws + WS_RV); ld = 512; c0 = (pn - 9) * 256; }
        else if (pn < 13) { base = (bf16*)(ws + WS_RG); ld = 512; c0 = (pn - 11) * 256; }
        else if (pn < 21) { base = (bf16*)(ws + WS_ZM); ld = 2048; c0 = (pn - 13) * 128; sig = true; }
        else { base = (bf16*)(ws + WS_ZG); ld = 32; c0 = 0; sig = true; narrow = true; }
        const bool merge = (pn >= 13 && pn < 21);
        const int row0 = u.pm * 256 + wr * 64 + fr;
#pragma unroll
        for (int ai = 0; ai < 2; ++ai)
#pragma unroll
            for (int m = 0; m < 4; ++m) {
                bf16* rowp = base + (size_t)(row0 + ai * 128 + m * 16) * ld + c0 + (narrow ? 0 : wc * 32) + 8 * fq;
                if (merge) {
                    float rr[8], gg[8];
#pragma unroll
                    for (int n = 0; n < 2; ++n)
#pragma unroll
                        for (int e = 0; e < 4; ++e) {
                            const float e0 = fminf(ex2(-acc[ai][0][m][n][e] * LOG2E), 1e30f), e1 = fminf(ex2(-acc[ai][1][m][n][e] * LOG2E), 1e30f);
                            const float g1 = __builtin_amdgcn_rcpf(1.f + e1);
                            gg[n * 4 + e] = g1; rr[n * 4 + e] = (1.f + e1) * __builtin_amdgcn_rcpf(1.f + e0);
                        }
                    u32x4 w; w.x = pk2(rr[0], rr[1]); w.y = pk2(rr[2], rr[3]); w.z = pk2(rr[4], rr[5]); w.w = pk2(rr[6], rr[7]);
                    *(u32x4*)rowp = w;
                    w.x = pk2(gg[0], gg[1]); w.y = pk2(gg[2], gg[3]); w.z = pk2(gg[4], gg[5]); w.w = pk2(gg[6], gg[7]);
                    *(u32x4*)(rowp + 1024) = w;
                    continue;
                }
#pragma unroll
                for (int bj = 0; bj < 2; ++bj) {
                    if (narrow && (bj != 0 || wc != 0)) continue;
                    f32x4 v0 = acc[ai][bj][m][0], v1 = acc[ai][bj][m][1];
                    if (sig) {
#pragma unroll
                        for (int e = 0; e < 4; ++e) { v0[e] = sigm(v0[e]); v1[e] = sigm(v1[e]); }
                    }
                    u32x4 w; w.x = pk2(v0[0], v0[1]); w.y = pk2(v0[2], v0[3]); w.z = pk2(v1[0], v1[1]); w.w = pk2(v1[2], v1[3]);
                    *(u32x4*)(rowp + bj * 128) = w;
                }
            }
    }
};
struct EpiMix {
    static constexpr bool PERM = true, AFTER_DRAIN = false, HAS_MID = true;
    const bf16* zm; bf16* mix;
    DI void mid(f32x4 (&acc)[2][2][4][2], const pg8::Unit& u, int wr, int wc, int fr, int fq) const {
        const int row0 = u.pm * 256 + wr * 64 + fr, col0 = u.pn * 256 + wc * 32 + 8 * fq;
        const bf16* gp = zm + (size_t)row0 * 2048 + col0;
#pragma unroll
        for (int ai = 0; ai < 2; ++ai) {
#pragma unroll
            for (int m = 0; m < 4; ++m) {
                asm volatile("" : "+v"(gp));
#pragma unroll
                for (int bj = 0; bj < 2; ++bj) {
                    const u32x4 ga = *(const u32x4*)(gp + bj * 128);
#pragma unroll
                    for (int e = 0; e < 4; ++e) {
                        acc[ai][bj][m][e >> 1][(e & 1) * 2] *= lo16(ga[e]); acc[ai][bj][m][e >> 1][(e & 1) * 2 + 1] *= hi16(ga[e]);
                    }
                }
                gp += (size_t)16 * 2048;
            }
            gp += (size_t)64 * 2048;
        }
    }
    DI void operator()(const f32x4 (&acc)[2][2][4][2], const pg8::Unit& u, int wr, int wc, int fr, int fq) const {
        const int row0 = u.pm * 256 + wr * 64 + fr, col0 = u.pn * 256 + wc * 32 + 8 * fq;
#pragma unroll
        for (int ai = 0; ai < 2; ++ai)
#pragma unroll
            for (int m = 0; m < 4; ++m) {
                const size_t row = (size_t)(row0 + ai * 128 + m * 16);
#pragma unroll
                for (int bj = 0; bj < 2; ++bj) {
                    const int col = col0 + bj * 128;
                    const u32x4 gt = *(const u32x4*)(zm + row * 2048 + 1024 + col);
                    const f32x4 a0 = acc[ai][bj][m][0], a1 = acc[ai][bj][m][1];
                    u32x4 w; w.x = pk2(a0[0] * lo16(gt.x), a0[1] * hi16(gt.x)); w.y = pk2(a0[2] * lo16(gt.y), a0[3] * hi16(gt.y));
                    w.z = pk2(a1[0] * lo16(gt.z), a1[1] * hi16(gt.z)); w.w = pk2(a1[2] * lo16(gt.w), a1[3] * hi16(gt.w));
                    *(u32x4*)(mix + row * 1024 + col) = w;
                }
            }
    }
};
struct EpiOut {
    static constexpr bool PERM = true, AFTER_DRAIN = false, HAS_MID = false;
    const float* x; float* out; bf16* x1b; float* ssq;
    DI void operator()(const f32x4 (&acc)[2][2][4][2], const pg8::Unit& u, int wr, int wc, int fr, int fq) const {
        const int row0 = u.pm * 256 + wr * 64 + fr, col0 = u.pn * 256 + wc * 32 + 8 * fq;
#pragma unroll
        for (int ai = 0; ai < 2; ++ai)
#pragma unroll
            for (int m = 0; m < 4; ++m) {
                const size_t row = (size_t)(row0 + ai * 128 + m * 16);
                float ss = 0.f;
#pragma unroll
                for (int bj = 0; bj < 2; ++bj) {
                    const size_t off = row * 1024 + col0 + bj * 128;
                    const f32x4 v0 = acc[ai][bj][m][0] + __builtin_nontemporal_load((const f32x4*)(x + off)), v1 = acc[ai][bj][m][1] + __builtin_nontemporal_load((const f32x4*)(x + off + 4));
                    u32x4 w; w.x = pk2(v0[0], v0[1]); w.y = pk2(v0[2], v0[3]); w.z = pk2(v1[0], v1[1]); w.w = pk2(v1[2], v1[3]);
                    *(u32x4*)(x1b + off) = w;
                    ss += (v0[0] * v0[0] + v0[1] * v0[1]) + (v0[2] * v0[2] + v0[3] * v0[3]) + (v1[0] * v1[0] + v1[1] * v1[1]) + (v1[2] * v1[2] + v1[3] * v1[3]);
                }
                ss += __shfl_xor(ss, 16); ss += __shfl_xor(ss, 32);
                if (fq == 0) ssq[row * 16 + u.pn * 4 + wc] = ss;
            }
    }
};
struct EpiFfn {
    static constexpr bool PERM = true, AFTER_DRAIN = false, HAS_MID = false;
    const LAS float* rstd_tab; bf16* hid; const float* ssq; int pm0;
    DI void operator()(const f32x4 (&acc)[2][2][4][2], const pg8::Unit& u, int wr, int wc, int fr, int fq) const {
        const int row0 = u.pm * 256 + wr * 64 + fr, col0 = u.pn * 128 + wc * 32 + 8 * fq;
#pragma unroll
        for (int ai = 0; ai < 2; ++ai)
#pragma unroll
            for (int m = 0; m < 4; ++m) {
                const size_t row = (size_t)(row0 + ai * 128 + m * 16);
                float rstd;
                if (u.pm == pm0) rstd = rstd_tab[wr * 64 + fr + ai * 128 + m * 16];
                else {
                    const float* sp = ssq + row * 16; float tot = 0.f;
#pragma unroll
                    for (int k = 0; k < 16; ++k) tot += sp[k];
                    rstd = rsqrtf(tot * (1.f / 1024.f) + EPS);
                }
                float v[8];
#pragma unroll
                for (int n = 0; n < 2; ++n)
#pragma unroll
                    for (int e = 0; e < 4; ++e) { const float gg = acc[ai][0][m][n][e] * rstd, uu = acc[ai][1][m][n][e] * rstd; v[n * 4 + e] = gg * sigm(gg) * uu; }
                u32x4 w; w.x = pk2(v[0], v[1]); w.y = pk2(v[2], v[3]); w.z = pk2(v[4], v[5]); w.w = pk2(v[6], v[7]);
                *(u32x4*)(hid + row * DFF + col0) = w;
            }
    }
};
struct EpiDown {
    static constexpr bool PERM = true, AFTER_DRAIN = false, HAS_MID = false;
    float* out; const bf16* x1b; int dry;
    DI void operator()(const f32x4 (&acc)[2][2][4][2], const pg8::Unit& u, int wr, int wc, int fr, int fq) const {
        const int row0 = u.pm * 256 + wr * 64 + fr, col0 = u.pn * 256 + wc * 32 + 8 * fq;
#pragma unroll
        for (int ai = 0; ai < 2; ++ai)
#pragma unroll
            for (int m = 0; m < 4; ++m) {
                const size_t row = (size_t)(row0 + ai * 128 + m * 16);
#pragma unroll
                for (int bj = 0; bj < 2; ++bj) {
                    float* p = out + row * 1024 + col0 + bj * 128;
                    const u32x4 xr = *(const u32x4*)(x1b + row * 1024 + col0 + bj * 128);
                    const f32x4 v0 = acc[ai][bj][m][0] + (f32x4){lo16(xr.x), hi16(xr.x), lo16(xr.y), hi16(xr.y)}, v1 = acc[ai][bj][m][1] + (f32x4){lo16(xr.z), hi16(xr.z), lo16(xr.w), hi16(xr.w)};
                    if (!dry) { *(f32x4*)p = v0; *(f32x4*)(p + 4) = v1; }
                }
            }
    }
};

template <class F> DI void tr_item(LAS float* scr, int lane, F src4, bf16* WT, int Kdst, int k0, int n0) {
    f32x4 v[8];
#pragma unroll
    for (int i = 0; i < 8; ++i) v[i] = src4(k0 + i * 8 + (lane >> 3), n0 + 4 * (lane & 7));
#pragma unroll
    for (int i = 0; i < 8; ++i) { LAS float* d = scr + (i * 8 + (lane >> 3)) * 33 + 4 * (lane & 7); d[0] = v[i][0]; d[1] = v[i][1]; d[2] = v[i][2]; d[3] = v[i][3]; }
    LDS_WAIT();
    const int c = lane & 7;
#pragma unroll
    for (int jj = 0; jj < 4; ++jj) {
        const int n = (lane >> 3) + 8 * jj; const LAS float* s = scr + (8 * c) * 33 + n;
        u32x4 o; o.x = pk2(s[0], s[33]); o.y = pk2(s[66], s[99]); o.z = pk2(s[132], s[165]); o.w = pk2(s[198], s[231]);
        *(u32x4*)(WT + (size_t)(n0 + n) * Kdst + k0 + 8 * c) = o;
    }
    LDS_WAIT();
}
DI void phase0(const Args& A, LAS unsigned char* lds, int tid, int lane, int wave, const int part, const int gw, const int NGW) {
    LAS float* scr = (LAS float*)(lds + wave * 16384);
    constexpr int I_IN = 16 * 176, I_GU = 16 * 176, I_DN = 44 * 32, I_WB = 2 * 8 * 32, I_WO = 16 * 32, I_W1 = 2 * 32 * 4 + 8;
    constexpr int NITEMS = I_IN + I_GU + I_DN + I_WB + I_WO + I_W1;
    unsigned char* ws = A.ws;
    for (int it = gw; it < NITEMS; it += NGW) {
        int r = it;
        const bool early = (r < I_IN) || (r >= NITEMS - I_W1);
        if (early != (part == 0)) continue;
        if (r < I_IN) {
            const float* W = A.win;
            auto src = [=](int k, int n) -> f32x4 {
                int c; if (n < 1280) c = n; else if (n < 3328) c = n + 24;
                else if (n < 5376) { const int q = n - 3328; c = 3352 + ((q >> 7) & 1) * 1024 + (q >> 8) * 128 + (q & 127); }
                else if (n < 5400) c = n - 5376 + 1280; else c = -1;
                return c >= 0 ? __builtin_nontemporal_load((const f32x4*)(W + (size_t)k * NIN + c)) : (f32x4){0.f, 0.f, 0.f, 0.f}; };
            tr_item(scr, lane, src, (bf16*)(ws + WS_WIN), 1024, (r / 176) * 64, (r % 176) * 32); continue; }
        r -= I_IN;
        if (r < I_GU) {
            const float* Wg = A.wg; const float* Wu = A.wu; const float* g2 = A.n2g;
            auto src = [=](int k, int n) -> f32x4 { const int tile = n >> 8, within = n & 255, j = tile * 128 + (within & 127);
                return g2[k] * __builtin_nontemporal_load((const f32x4*)(((within >> 7) ? Wu : Wg) + (size_t)k * DFF + j)); };
            tr_item(scr, lane, src, (bf16*)(ws + WS_WGU), 1024, (r / 176) * 64, (r % 176) * 32); continue; }
        r -= I_GU;
        if (r < I_DN) {
            const float* W = A.wd;
            auto src = [=](int k, int n) -> f32x4 { return __builtin_nontemporal_load((const f32x4*)(W + (size_t)k * 1024 + n)); };
            tr_item(scr, lane, src, (bf16*)(ws + WS_WDN), DFF, (r / 32) * 64, (r % 32) * 32); continue; }
        r -= I_DN;
        if (r < I_WB) {
            const float* W = A.wb;
            auto src = [=](int k, int n) -> f32x4 { return __builtin_nontemporal_load((const f32x4*)(W + (size_t)k * 1024 + n)); };
            tr_item(scr, lane, src, (bf16*)(ws + WS_WB), 1024, (r / 32) * 64, (r % 32) * 32); continue; }
        r -= I_WB;
        if (r < I_WO) {
            const float* W = A.wo;
            auto src = [=](int k, int n) -> f32x4 { return __builtin_nontemporal_load((const f32x4*)(W + (size_t)k * 1024 + n)); };
            tr_item(scr, lane, src, (bf16*)(ws + WS_WO), 1024, (r / 32) * 64, (r % 32) * 32); continue; }
        r -= I_WO;
        if (r >= 256) {
            const int which = (r - 256) >> 2, rr = (r - 256) & 3; const float* W = A.w2 + (size_t)which * 128 * 64;
            auto src = [=](int k, int n) -> f32x4 { return *(const f32x4*)(W + (size_t)k * 64 + n); };
            tr_item(scr, lane, src, (bf16*)(ws + WS_W2T) + (size_t)which * 64 * 128, 128, (rr >> 1) * 64, (rr & 1) * 32);
        } else {
            const int which = r / 128, rr = r % 128; const float* W = A.w1 + (size_t)which * 2048 * 128;
            auto src = [=](int k, int n) -> f32x4 { return *(const f32x4*)(W + (size_t)k * 128 + n); };
            tr_item(scr, lane, src, (bf16*)(ws + WS_W1T) + (size_t)which * 128 * 2048, 2048, (rr / 4) * 64, (rr % 4) * 32);
        }
    }
    if (part != 0) return;
    bf16* H = (bf16*)(ws + WS_H);
    f32x4 gv[4];
#pragma unroll
    for (int j = 0; j < 4; ++j) gv[j] = ((const f32x4*)A.n1g)[lane + 64 * j];
    for (int m = gw; m < M; m += 2 * NGW) {
        const int m2 = m + NGW; const bool has2 = m2 < M;
        const f32x4* xr = (const f32x4*)(A.x + (size_t)m * DM) + lane;
        const f32x4* xr2 = (const f32x4*)(A.x + (size_t)(has2 ? m2 : m) * DM) + lane;
        f32x4 v[4], w[4]; float s = 0.f, s2 = 0.f;
#pragma unroll
        for (int j = 0; j < 4; ++j) { v[j] = __builtin_nontemporal_load(xr + 64 * j); w[j] = __builtin_nontemporal_load(xr2 + 64 * j); }
#pragma unroll
        for (int j = 0; j < 4; ++j) { s += (v[j][0] * v[j][0] + v[j][1] * v[j][1]) + (v[j][2] * v[j][2] + v[j][3] * v[j][3]); s2 += (w[j][0] * w[j][0] + w[j][1] * w[j][1]) + (w[j][2] * w[j][2] + w[j][3] * w[j][3]); }
        const float rstd = rsqrtf(wave_sum(s) * (1.f / DM) + EPS), rstd2 = rsqrtf(wave_sum(s2) * (1.f / DM) + EPS);
        u32x2* o8 = (u32x2*)(H + (size_t)m * DM) + lane;
#pragma unroll
        for (int j = 0; j < 4; ++j) { u32x2 ww; ww.x = pk2(v[j][0] * rstd * gv[j][0], v[j][1] * rstd * gv[j][1]); ww.y = pk2(v[j][2] * rstd * gv[j][2], v[j][3] * rstd * gv[j][3]); o8[64 * j] = ww; }
        if (has2) {
            u32x2* p8 = (u32x2*)(H + (size_t)m2 * DM) + lane;
#pragma unroll
            for (int j = 0; j < 4; ++j) { u32x2 ww; ww.x = pk2(w[j][0] * rstd2 * gv[j][0], w[j][1] * rstd2 * gv[j][1]); ww.y = pk2(w[j][2] * rstd2 * gv[j][2], w[j][3] * rstd2 * gv[j][3]); p8[64 * j] = ww; }
        }
    }
    const int gt = blockIdx.x * 512 + tid;
    if (gt < 8192) {
        const int kv = gt >> 12, l = (gt >> 7) & 31, f = gt & 127;
        const float* pe = A.pe + (kv * 32 + l) * 64; const float* w1 = A.w1 + ((size_t)(kv * 32 + l) * 64) * 128 + f;
        float s = 0.f;
#pragma unroll 8
        for (int d = 0; d < 64; ++d) s += pe[d] * w1[(size_t)d * 128];
        ((float*)(ws + WS_BIASP))[gt] = s;
    }
}

DI void kvprep_unit(const Args& A, LAS unsigned char* lds, int u, int lane, int wave) {
    unsigned char* ws = A.ws;
    const int b = u >> 5, tile = u & 31;
    const int br = 1 + (wave >> 2), g = (wave >> 1) & 1, kind = wave & 1;
    const int tl = lane >> 3, ch = lane & 7;
    const bf16* src = (const bf16*)(ws + WS_ZKV) + (size_t)(b * SEQ + tile * 64 + tl) * 768 + br * 256 + kind * 128 + g * 64 + 8 * ch;
    u32x4 v[8];
#pragma unroll
    for (int it = 0; it < 8; ++it) v[it] = __builtin_nontemporal_load((const u32x4*)(src + (size_t)it * 8 * 768));
    const size_t slab = (size_t)(((br - 1) * 8 + b) * 2 + g);
    if (kind == 0) {
        const float* kg = A.kg + br * 64 + 8 * ch;
        float kgv[8];
#pragma unroll
        for (int e = 0; e < 8; ++e) kgv[e] = kg[e];
        bf16* dst = (bf16*)(ws + WS_KN) + (slab * 2048 + tile * 64 + tl) * 64 + 8 * ch;
#pragma unroll
        for (int it = 0; it < 8; ++it) {
            float ss = 0.f;
#pragma unroll
            for (int e = 0; e < 4; ++e) { const float a = lo16(v[it][e]), c = hi16(v[it][e]); ss += a * a + c * c; }
            ss += __shfl_xor(ss, 1); ss += __shfl_xor(ss, 2); ss += __shfl_xor(ss, 4);
            const float rstd = rsqrtf(ss * (1.f / 64.f) + EPS);
            u32x4 w;
#pragma unroll
            for (int e = 0; e < 4; ++e) w[e] = pk2(lo16(v[it][e]) * rstd * kgv[2 * e], hi16(v[it][e]) * rstd * kgv[2 * e + 1]);
            *(u32x4*)(dst + (size_t)it * 8 * 64) = w;
        }
    } else {
        LAS unsigned char* T = lds + wave * 9344;
#pragma unroll
        for (int it = 0; it < 8; ++it) {
            const int t = it * 8 + tl, pos = (t & ~15) | perm16(t & 15);
#pragma unroll
            for (int e = 0; e < 4; ++e) {
                const int d0 = 8 * ch + 2 * e;
                *(LAS bf16*)(T + d0 * 144 + ch * 16 + pos * 2) = (bf16)(v[it][e] & 0xffffu);
                *(LAS bf16*)(T + (d0 + 1) * 144 + ch * 16 + pos * 2) = (bf16)(v[it][e] >> 16);
            }
        }
        LDS_WAIT();
        bf16* dst = (bf16*)(ws + WS_VT) + slab * 64 * 2048 + tile * 64;
#pragma unroll
        for (int q = 0; q < 8; ++q) { const int idx = q * 64 + lane, d = idx >> 3, c8 = idx & 7;
            const u32x4 w = *(const LAS u32x4*)(T + d * 144 + (d >> 3) * 16 + c8 * 16);
            *(u32x4*)(dst + (size_t)d * 2048 + c8 * 8) = w; }
        LDS_WAIT();
    }
    __syncthreads();
}

DI float gelu_tanh(float x) {
    const float y = 0.7978845608028654f * (x + 0.044715f * x * x * x);
    const float e = ex2(2.f * LOG2E * y);
    const float t = 1.f - 2.f * __builtin_amdgcn_rcpf(e + 1.f);
    return 0.5f * x * (1.f + t);
}
DI void compress_unit(const Args& A, LAS unsigned char* lds, int u, int tid, int lane, int wave) {
    unsigned char* ws = A.ws;
    const int b = u >> 4, g = (u >> 3) & 1, kv = (u >> 2) & 1, nq = u & 3;
    const int r = lane & 31, h = lane >> 5, fb = wave & 3, kh = wave >> 2;
    const int n0 = nq * 32;
    LAS unsigned char* XL = lds;
    LAS float* RED = (LAS float*)(lds + 77824);
    {
        const bf16* xs = (const bf16*)(ws + WS_ZKV) + (size_t)(b * SEQ) * 768 + kv * 128 + g * 64 + 8 * (tid & 7);
#pragma unroll
        for (int q = 0; q < 9; ++q) {
            const int t = q * 64 + (tid >> 3);
            if (t < 528) {
                const int tok = 16 * n0 + t;
                u32x4 v = (u32x4){0u, 0u, 0u, 0u};
                if (tok < SEQ) v = __builtin_nontemporal_load((const u32x4*)(xs + (size_t)tok * 768));
                *(LAS u32x4*)(XL + t * 144 + (t >> 4) * 16 + (tid & 7) * 16) = v;
            }
        }
    }
    float bias = 0.f;
    if (kh == 0) {
        const float* bp2 = (const float*)(ws + WS_BIASP) + kv * 32 * 128 + fb * 32 + r;
#pragma unroll
        for (int l = 0; l < 32; ++l) bias += bp2[l * 128];
    }
    const bf16* bp = (const bf16*)(ws + WS_W1T) + (size_t)(kv * 128 + fb * 32 + r) * 2048 + 8 * h;
    f32x16 acc = zero16();
    u32x4 bv[8][4];
#pragma unroll
    for (int li = 0; li < 8; ++li)
#pragma unroll
        for (int j = 0; j < 4; ++j) bv[li][j] = *(const u32x4*)(bp + (kh * 16 + li) * 64 + 16 * j);
    __syncthreads();
#pragma unroll 1
    for (int l0 = kh * 16; l0 < kh * 16 + 16; l0 += 8) {
        if (l0 != kh * 16) {
#pragma unroll
            for (int li = 0; li < 8; ++li)
#pragma unroll
                for (int j = 0; j < 4; ++j) bv[li][j] = *(const u32x4*)(bp + (l0 + li) * 64 + 16 * j);
        }
#pragma unroll
        for (int li = 0; li < 8; ++li) {
            const int t = 16 * r + l0 + li;
#pragma unroll
            for (int j = 0; j < 4; ++j) {
                const bf16x8 a = *(const LAS bf16x8*)(XL + t * 144 + (t >> 4) * 16 + (16 * j + 8 * h) * 2);
                acc = MFMA32(a, __builtin_bit_cast(bf16x8, bv[li][j]), acc);
            }
        }
    }
    if (kh == 1) {
#pragma unroll
        for (int reg = 0; reg < 16; ++reg) RED[crow(reg, h) * 132 + fb * 32 + r] = acc[reg];
    }
    __syncthreads();
    if (kh == 0) {
        const int f = fb * 32 + r;
#pragma unroll
        for (int reg = 0; reg < 16; ++reg) { const int o = crow(reg, h) * 132 + f; RED[o] = gelu_tanh(acc[reg] + RED[o] + bias); }
    }
    __syncthreads();
    if (wave == 0) {
        const bf16* w2t = (const bf16*)(ws + WS_W2T) + (size_t)(kv * 64 + r) * 128 + 8 * h;
        u32x4 wv[2][8];
#pragma unroll
        for (int db = 0; db < 2; ++db)
#pragma unroll
            for (int ks = 0; ks < 8; ++ks) wv[db][ks] = *(const u32x4*)(w2t + (size_t)db * 32 * 128 + ks * 16);
        f32x16 o0 = zero16(), o1 = zero16();
#pragma unroll
        for (int ks = 0; ks < 8; ++ks) {
            const f32x4 x0 = *(const LAS f32x4*)(RED + r * 132 + ks * 16 + 8 * h), x1 = *(const LAS f32x4*)(RED + r * 132 + ks * 16 + 8 * h + 4);
            u32x4 aw; aw.x = pk2(x0[0], x0[1]); aw.y = pk2(x0[2], x0[3]); aw.z = pk2(x1[0], x1[1]); aw.w = pk2(x1[2], x1[3]);
            const bf16x8 af = __builtin_bit_cast(bf16x8, aw);
            o0 = MFMA32(af, __builtin_bit_cast(bf16x8, wv[0][ks]), o0);
            o1 = MFMA32(af, __builtin_bit_cast(bf16x8, wv[1][ks]), o1);
        }
        const size_t bg = (size_t)(b * 2 + g);
        if (kv == 0) {
            const float kg0 = A.kg[r], kg1 = A.kg[32 + r];
#pragma unroll
            for (int reg = 0; reg < 16; ++reg) {
                float ss = o0[reg] * o0[reg] + o1[reg] * o1[reg];
                ss += __shfl_xor(ss, 1); ss += __shfl_xor(ss, 2); ss += __shfl_xor(ss, 4); ss += __shfl_xor(ss, 8); ss += __shfl_xor(ss, 16);
                const float rstd = rsqrtf(ss * (1.f / 64.f) + EPS); const int nn = n0 + crow(reg, h);
                bf16* dst = (bf16*)(ws + WS_KC) + (bg * 128 + nn) * 64;
                dst[r] = f2bf(nn < 127 ? o0[reg] * rstd * kg0 : 0.f); dst[32 + r] = f2bf(nn < 127 ? o1[reg] * rstd * kg1 : 0.f);
            }
        } else {
#pragma unroll
            for (int reg = 0; reg < 16; ++reg) {
                const int nn = n0 + crow(reg, h), pp = (nn & ~15) | perm16(nn & 15);
                bf16* dst = (bf16*)(ws + WS_VCT) + bg * 64 * 128 + pp;
                dst[(size_t)r * 128] = f2bf(nn < 127 ? o0[reg] : 0.f); dst[(size_t)(32 + r) * 128] = f2bf(nn < 127 ? o1[reg] : 0.f);
            }
        }
    }
    __syncthreads();
}

DI void rstate_group(const Args& A, LAS unsigned char* lds, int ug, int tid, int lane, int wave) {
    unsigned char* ws = A.ws;
    const int b = ug >> 4, hh = (ug >> 2) & 3, mg = ug & 3;
    LAS bf16* KT = (LAS bf16*)lds;
    LAS bf16* VTL = (LAS bf16*)(lds + 35328);
    const float lg = log2f(1.f - exp2f(-5.f - (float)hh));
    const float cd = ex2(128.f * lg);
    const int r = lane & 31, h = lane >> 5, eb = wave >> 1;
    f32x16 R0 = zero16(), R1 = zero16();
    u32x4 kxv[4], vxv[4];
#pragma unroll
    for (int q = 0; q < 4; ++q) {
        const int idx = q * 512 + tid, j = idx >> 4, ch = idx & 15;
        const size_t row = (size_t)(b * SEQ + (mg * 4) * 128 + j) * 512 + hh * 128 + ch * 8;
        kxv[q] = *(const u32x4*)((const bf16*)(ws + WS_RK) + row); vxv[q] = *(const u32x4*)((const bf16*)(ws + WS_RV) + row);
    }
#pragma unroll 1
    for (int k = 0; k < 4; ++k) {
        const int c = mg * 4 + k;
#pragma unroll
        for (int q = 0; q < 4; ++q) {
            const int idx = q * 512 + tid, j = idx >> 4, ch = idx & 15;
            const u32x4 kx = kxv[q], vx = vxv[q];
            const float sc = ex2((float)(127 - j) * lg) * 0.08838834764831845f;
#pragma unroll
            for (int e = 0; e < 4; ++e) {
                KT[(ch * 8 + 2 * e) * 136 + ch * 8 + j] = f2bf(lo16(kx[e]) * sc); KT[(ch * 8 + 2 * e + 1) * 136 + ch * 8 + j] = f2bf(hi16(kx[e]) * sc);
                VTL[(ch * 8 + 2 * e) * 136 + ch * 8 + j] = (bf16)(vx[e] & 0xffffu); VTL[(ch * 8 + 2 * e + 1) * 136 + ch * 8 + j] = (bf16)(vx[e] >> 16);
            }
        }
        if (k < 3) {
#pragma unroll
            for (int q = 0; q < 4; ++q) {
                const int idx = q * 512 + tid, j = idx >> 4, ch = idx & 15;
                const size_t row = (size_t)(b * SEQ + (c + 1) * 128 + j) * 512 + hh * 128 + ch * 8;
                kxv[q] = *(const u32x4*)((const bf16*)(ws + WS_RK) + row); vxv[q] = *(const u32x4*)((const bf16*)(ws + WS_RV) + row);
            }
        }
        __syncthreads();
        bf16* dst = (bf16*)(ws + WS_KVT) + (size_t)((b * 4 + hh) * 16 + c) * 16384;
#pragma unroll
        for (int dbi = 0; dbi < 2; ++dbi) {
            const int db = (wave & 1) * 2 + dbi; f32x16 acc = zero16();
#pragma unroll
            for (int ks = 0; ks < 8; ++ks) {
                const bf16x8 a = *(const LAS bf16x8*)(VTL + (eb * 32 + r) * 136 + ((eb * 32 + r) >> 3) * 8 + ks * 16 + 8 * h);
                const bf16x8 bb = *(const LAS bf16x8*)(KT + (db * 32 + r) * 136 + ((db * 32 + r) >> 3) * 8 + ks * 16 + 8 * h);
                acc = MFMA32(a, bb, acc);
            }
            if (dbi == 0) {
#pragma unroll
                for (int reg = 0; reg < 16; ++reg) { R0[reg] = R0[reg] * cd + acc[reg]; dst[(size_t)(eb * 32 + crow(reg, h)) * 128 + db * 32 + r] = f2bf(R0[reg]); }
            } else {
#pragma unroll
                for (int reg = 0; reg < 16; ++reg) { R1[reg] = R1[reg] * cd + acc[reg]; dst[(size_t)(eb * 32 + crow(reg, h)) * 128 + db * 32 + r] = f2bf(R1[reg]); }
            }
        }
        __syncthreads();
    }
}

DI void rout_unit(const Args& A, LAS unsigned char* lds, int u, int tid, int lane, int wave, const bool dry) {
    unsigned char* ws = A.ws;
    const int b = u >> 6, hh = (u >> 4) & 3, c = u & 15;
    LAS bf16* KL = (LAS bf16*)lds;
    LAS bf16* VTL = (LAS bf16*)(lds + 34816);
    LAS bf16* STL = (LAS bf16*)(lds + 70144);
    const float lg = log2f(1.f - exp2f(-5.f - (float)hh));
    u32x4 qraw[8]; u32x2 graw[16];
    if (wave < 4) {
        const int r_ = lane & 31, h_ = lane >> 5;
        const size_t tok_ = (size_t)(b * SEQ + c * 128 + wave * 32 + r_);
        const bf16* qp_ = (const bf16*)(ws + WS_RQ) + tok_ * 512 + hh * 128 + 8 * h_;
        const bf16* gp_ = (const bf16*)(ws + WS_RG) + tok_ * 512 + hh * 128 + 4 * h_;
#pragma unroll
        for (int ks = 0; ks < 8; ++ks) qraw[ks] = *(const u32x4*)(qp_ + ks * 16);
#pragma unroll
        for (int eb = 0; eb < 4; ++eb)
#pragma unroll
            for (int g4 = 0; g4 < 4; ++g4) graw[eb * 4 + g4] = *(const u32x2*)(gp_ + eb * 32 + 8 * g4);
    }
    {
        float sa[4][8];
#pragma unroll
        for (int q = 0; q < 4; ++q)
#pragma unroll
            for (int e = 0; e < 8; ++e) sa[q][e] = 0.f;
#pragma unroll
        for (int q = 0; q < 4; ++q) {
            const int idx = q * 512 + tid, j = idx >> 4, ch = idx & 15;
            const size_t row = (size_t)(b * SEQ + c * 128 + j) * 512 + hh * 128 + ch * 8;
            const u32x4 kx = *(const u32x4*)((const bf16*)(ws + WS_RK) + row), vx = *(const u32x4*)((const bf16*)(ws + WS_RV) + row);
            *(LAS u32x4*)(KL + j * 136 + ch * 8) = kx;
            const int pos = (j & ~15) | perm16(j & 15);
#pragma unroll
            for (int e = 0; e < 4; ++e) { VTL[(ch * 8 + 2 * e) * 136 + ch * 8 + pos] = (bf16)(vx[e] & 0xffffu); VTL[(ch * 8 + 2 * e + 1) * 136 + ch * 8 + pos] = (bf16)(vx[e] >> 16); }
        }
        const bf16* kvt = (const bf16*)(ws + WS_KVT) + (size_t)((b * 4 + hh) * 16) * 16384;
        {
            const int mg = c >> 2;
            int cps[4]; float wts[4];
            cps[0] = (c & 3) ? c - 1 : 0; wts[0] = (c & 3) ? 1.f : 0.f;
#pragma unroll
            for (int k = 1; k < 4; ++k) { const int mp = k - 1; cps[k] = (mp < mg) ? 4 * mp + 3 : 0; wts[k] = (mp < mg) ? ex2(128.f * (float)(c - 4 * mp - 4) * lg) : 0.f; }
            u32x4 xx[4][4];
#pragma unroll
            for (int k = 0; k < 4; ++k)
#pragma unroll
                for (int q = 0; q < 4; ++q) xx[k][q] = *(const u32x4*)(kvt + (size_t)cps[k] * 16384 + (q * 512 + tid) * 8);
#pragma unroll
            for (int k = 0; k < 4; ++k)
#pragma unroll
                for (int q = 0; q < 4; ++q)
#pragma unroll
                    for (int e = 0; e < 4; ++e) { sa[q][2 * e] += wts[k] * lo16(xx[k][q][e]); sa[q][2 * e + 1] += wts[k] * hi16(xx[k][q][e]); }
        }
#pragma unroll
        for (int q = 0; q < 4; ++q) {
            const int idx = q * 512 + tid, e = idx >> 4, ch = idx & 15;
            u32x4 w; w.x = pk2(sa[q][0], sa[q][1]); w.y = pk2(sa[q][2], sa[q][3]); w.z = pk2(sa[q][4], sa[q][5]); w.w = pk2(sa[q][6], sa[q][7]);
            *(LAS u32x4*)(STL + e * 136 + ch * 8) = w;
        }
    }
    __syncthreads();
    if (wave < 4) {
        const int r = lane & 31, h = lane >> 5, ib = wave, i = ib * 32 + r;
        const size_t tok = (size_t)(b * SEQ + c * 128 + i);
        bf16x8 qf[8], qdf[8];
        {
            const bf16* qp = (const bf16*)(ws + WS_RQ) + tok * 512 + hh * 128 + 8 * h;
            const float qd = ex2((float)(i + 1) * lg);
#pragma unroll
            for (int ks = 0; ks < 8; ++ks) {
                const u32x4 xx = qraw[ks];
                qf[ks] = __builtin_bit_cast(bf16x8, xx);
                u32x4 y;
#pragma unroll
                for (int e = 0; e < 4; ++e) y[e] = pk2(lo16(xx[e]) * qd, hi16(xx[e]) * qd);
                qdf[ks] = __builtin_bit_cast(bf16x8, y);
            }
        }
        f32x16 o[4];
#pragma unroll
        for (int eb = 0; eb < 4; ++eb) o[eb] = zero16();
#pragma unroll
        for (int jb = 0; jb < 4; ++jb) {
            if (jb <= ib) {
                f32x16 s = zero16();
#pragma unroll
                for (int ks = 0; ks < 8; ++ks) s = MFMA32(*(const LAS bf16x8*)(KL + (jb * 32 + r) * 136 + ks * 16 + 8 * h), qf[ks], s);
#pragma unroll
                for (int reg = 0; reg < 16; ++reg) { const int diff = i - (jb * 32 + crow(reg, h));
                    s[reg] *= (diff >= 0) ? ex2((float)diff * lg) * 0.08838834764831845f : 0.f; }
#pragma unroll
                for (int s2 = 0; s2 < 2; ++s2) {
                    const bf16x8 pf = pack8(s, s2);
#pragma unroll
                    for (int eb = 0; eb < 4; ++eb) o[eb] = MFMA32(*(const LAS bf16x8*)(VTL + (eb * 32 + r) * 136 + ((eb * 32 + r) >> 3) * 8 + jb * 32 + s2 * 16 + 8 * h), pf, o[eb]);
                }
            }
        }
#pragma unroll
        for (int eb = 0; eb < 4; ++eb)
#pragma unroll
            for (int ks = 0; ks < 8; ++ks) o[eb] = MFMA32(*(const LAS bf16x8*)(STL + (eb * 32 + r) * 136 + ks * 16 + 8 * h), qdf[ks], o[eb]);
        float sm = 0.f;
#pragma unroll
        for (int eb = 0; eb < 4; ++eb)
#pragma unroll
            for (int reg = 0; reg < 16; ++reg) sm += o[eb][reg];
        sm += __shfl_xor(sm, 32);
        const float mu = sm * (1.f / 128.f);
        float vq = 0.f;
#pragma unroll
        for (int eb = 0; eb < 4; ++eb)
#pragma unroll
            for (int reg = 0; reg < 16; ++reg) { const float dd = o[eb][reg] - mu; vq += dd * dd; }
        vq += __shfl_xor(vq, 32);
        const float rstd = rsqrtf(vq * (1.f / 128.f) + EPS);
        const bf16* gp = (const bf16*)(ws + WS_RG) + tok * 512 + hh * 128;
        bf16* yp = (bf16*)(ws + WS_Y) + tok * 1024 + 512 + hh * 128;
        const float* gn = A.gng + hh * 128;
#pragma unroll
        for (int eb = 0; eb < 4; ++eb)
#pragma unroll
            for (int g4 = 0; g4 < 4; ++g4) {
                const int e0 = eb * 32 + 8 * g4 + 4 * h;
                const u32x2 gv = graw[eb * 4 + g4]; const f32x4 gw = *(const f32x4*)(gn + e0);
                float y[4];
#pragma unroll
                for (int k = 0; k < 4; ++k) { const float gg = (k & 1) ? hi16(gv[k >> 1]) : lo16(gv[k >> 1]); y[k] = (o[eb][4 * g4 + k] - mu) * rstd * gw[k] * (gg * sigm(gg)); }
                u32x2 w; w.x = pk2(y[0], y[1]); w.y = pk2(y[2], y[3]);
                if (!dry) *(u32x2*)(yp + e0) = w;
            }
    }
    __syncthreads();
}

DI bf16x8 aug_k(int off, int h) {
    const unsigned o = (unsigned)f2bf((float)off);
    u32x4 w; w.x = h ? 0u : (o | (o << 16)); w.y = h ? 0u : 0x3f803f80u; w.z = h ? 0u : 0x00003f80u; w.w = 0u;
    return __builtin_bit_cast(bf16x8, w);
}
DI bf16x8 aug_q(unsigned slope_pk, float base, int h) {
    const unsigned b0 = (unsigned)f2bf(base); const float r1 = base - bf2f((unsigned short)b0);
    const unsigned b1 = (unsigned)f2bf(r1); const float r2 = r1 - bf2f((unsigned short)b1);
    const unsigned b2 = (unsigned)f2bf(r2);
    u32x4 w; w.x = h ? 0u : slope_pk; w.y = h ? 0u : (b0 | (b1 << 16)); w.z = h ? 0u : b2; w.w = 0u;
    return __builtin_bit_cast(bf16x8, w);
}
DI void nsa_tile(const int MASK, LAS unsigned char* kbuf, LAS unsigned char* vbuf, const bf16x8 (&qf)[4], const bf16x8 (&ka)[2], bf16x8 qa, int kt, int tq, int r, int h,
                 float& l, f32x16& o0, f32x16& o1) {
    bf16x8 kf[8];
#pragma unroll
    for (int j = 0; j < 4; ++j) { kf[2 * j] = *(const LAS bf16x8*)(kbuf + r * 144 + (16 * j + 8 * h) * 2); kf[2 * j + 1] = *(const LAS bf16x8*)(kbuf + (32 + r) * 144 + (16 * j + 8 * h) * 2); }
    __builtin_amdgcn_sched_barrier(0);
    f32x16 s0 = zero16(), s1 = zero16();
#pragma unroll
    for (int j = 0; j < 4; ++j) { s0 = MFMA32(kf[2 * j], qf[j], s0); s1 = MFMA32(kf[2 * j + 1], qf[j], s1); }
    s0 = MFMA32(ka[0], qa, s0); s1 = MFMA32(ka[1], qa, s1);
    bf16x8 vf[8];
#pragma unroll
    for (int s2 = 0; s2 < 2; ++s2) {
        vf[4 * s2 + 0] = *(const LAS bf16x8*)(vbuf + r * 144 + (s2 * 16 + 8 * h) * 2);
        vf[4 * s2 + 1] = *(const LAS bf16x8*)(vbuf + (32 + r) * 144 + (s2 * 16 + 8 * h) * 2);
        vf[4 * s2 + 2] = *(const LAS bf16x8*)(vbuf + r * 144 + (32 + s2 * 16 + 8 * h) * 2);
        vf[4 * s2 + 3] = *(const LAS bf16x8*)(vbuf + (32 + r) * 144 + (32 + s2 * 16 + 8 * h) * 2);
    }
    __builtin_amdgcn_sched_barrier(0);
    float rs = 0.f;
    if (MASK != 0) {
        const int lo = (MASK == 2) ? tq - 511 : -(1 << 30);
#pragma unroll
        for (int reg = 0; reg < 16; ++reg) {
            const int kp0 = kt * 64 + crow(reg, h), kp1 = kp0 + 32;
            s0[reg] = (kp0 <= tq && kp0 >= lo) ? s0[reg] : NEGINF; s1[reg] = (kp1 <= tq && kp1 >= lo) ? s1[reg] : NEGINF;
        }
    }
#pragma unroll
    for (int reg = 0; reg < 16; ++reg) { s0[reg] = ex2(s0[reg]); s1[reg] = ex2(s1[reg]); rs += s0[reg] + s1[reg]; }
    l += rs;
#pragma unroll
    for (int s2 = 0; s2 < 2; ++s2) {
        const bf16x8 p0 = pack8(s0, s2), p1 = pack8(s1, s2);
        o0 = MFMA32(vf[4 * s2 + 0], p0, o0);
        o1 = MFMA32(vf[4 * s2 + 1], p0, o1);
        o0 = MFMA32(vf[4 * s2 + 2], p1, o0);
        o1 = MFMA32(vf[4 * s2 + 3], p1, o1);
    }
}
template <int MODE>
DI void nsa_branch(LAS unsigned char* lds, unsigned list, const bf16* kbase, const bf16* vbase, const bf16x8 (&qf)[4], const bf16x8 (&ka)[2], unsigned slope_pk,
                   int tile, int tq, unsigned sel, float slope2, float gate, int r, int h, int tid, LAS float* otl, const bool dry) {
#ifndef PROBE_NSA_MODE
#define PROBE_NSA_MODE 0
#endif
    const bool nocomp = dry && PROBE_NSA_MODE == 1, nostage = dry && PROBE_NSA_MODE == 2;
    const int srow = tid >> 3, sch = tid & 7;
    float l = 0.f; f32x16 o0 = zero16(), o1 = zero16();
    int buf = 0;
    {
        const int kt = __builtin_ctz(list);
        const u32x4 kx = *(const u32x4*)(kbase + (size_t)(kt * 64 + srow) * 64 + sch * 8);
        const u32x4 vx = *(const u32x4*)(vbase + (size_t)srow * 2048 + kt * 64 + sch * 8);
        *(LAS u32x4*)(lds + srow * 144 + sch * 16) = kx;
        *(LAS u32x4*)(lds + 18432 + srow * 144 + sch * 16) = vx;
    }
    __syncthreads();
    while (list) {
        const int kt = __builtin_ctz(list); list &= list - 1u;
        u32x4 kx, vx;
        if (list && !nostage) {
            const int nk = __builtin_ctz(list);
            kx = *(const u32x4*)(kbase + (size_t)(nk * 64 + srow) * 64 + sch * 8);
            vx = *(const u32x4*)(vbase + (size_t)srow * 2048 + nk * 64 + sch * 8);
        }
        const bool lanesel = (MODE == 1) ? (((sel >> kt) & 1u) != 0u) : true;
        const bool act = (MODE == 1) ? (__ballot(lanesel) != 0ull) : true;
        if (act && !nocomp) {
            const bf16x8 qa = aug_q(slope_pk, lanesel ? slope2 * (float)(kt * 64 - tq) : -30000.f, h);
            LAS unsigned char* kb_ = lds + buf * 9216; LAS unsigned char* vb_ = lds + 18432 + buf * 9216;
            const int mask = (kt == tile) ? 1 : ((MODE == 0 && kt == tile - 8) ? 2 : 0);
            nsa_tile(mask, kb_, vb_, qf, ka, qa, kt, tq, r, h, l, o0, o1);
        }
        if (list && !nostage) {
            *(LAS u32x4*)(lds + (buf ^ 1) * 9216 + srow * 144 + sch * 16) = kx;
            *(LAS u32x4*)(lds + 18432 + (buf ^ 1) * 9216 + srow * 144 + sch * 16) = vx;
        }
        __syncthreads();
        buf ^= 1;
    }
    const float lt = l + __shfl_xor(l, 32);
    const float sc = (lt > 0.f) ? gate / lt : 0.f;
#pragma unroll
    for (int reg = 0; reg < 16; ++reg) { otl[reg * 64] += sc * o0[reg]; otl[(16 + reg) * 64] += sc * o1[reg]; }
}

DI void nsa_unit(const Args& A, LAS unsigned char* lds, int b, int g, int tile, int tid, int lane, int wave, const bool dry) {
    unsigned char* ws = A.ws;
    LAS unsigned* UNI = (LAS unsigned*)(lds + 36864);
    const int r = lane & 31, h = lane >> 5;
    const int t0 = tile * 64, tq = t0 + wave * 8 + (r >> 2), hd = g * 4 + (r & 3);
    const float slope2 = ex2(-(float)(hd + 1)) * LOG2E;
    unsigned slope_pk; { const unsigned sh = (unsigned)f2bf(slope2); const unsigned sl = (unsigned)f2bf(slope2 - bf2f((unsigned short)sh)); slope_pk = sh | (sl << 16); }
    bf16x8 ka[2]; ka[0] = aug_k(r, h); ka[1] = aug_k(32 + r, h);
    const size_t tokrow = (size_t)(b * SEQ + tq);
    const size_t bg = (size_t)(b * 2 + g);
    const int srow = tid >> 3, sch = tid & 7;
    bf16x8 qf[4];
    {
        const bf16* qp = (const bf16*)(ws + WS_ZQ) + tokrow * 512 + hd * 64 + 8 * h;
        u32x4 raw[4]; float ss = 0.f;
#pragma unroll
        for (int j = 0; j < 4; ++j) { raw[j] = *(const u32x4*)(qp + 16 * j);
#pragma unroll
            for (int e = 0; e < 4; ++e) { const float a = lo16(raw[j][e]), c = hi16(raw[j][e]); ss += a * a + c * c; } }
        ss += __shfl_xor(ss, 32);
        const float rstd = rsqrtf(ss * (1.f / 64.f) + EPS) * (0.125f * LOG2E);
#pragma unroll
        for (int j = 0; j < 4; ++j) { u32x4 y; const float* qg = A.qg + 16 * j + 8 * h;
#pragma unroll
            for (int e = 0; e < 4; ++e) y[e] = pk2(lo16(raw[j][e]) * rstd * qg[2 * e], hi16(raw[j][e]) * rstd * qg[2 * e + 1]);
            qf[j] = __builtin_bit_cast(bf16x8, y); }
    }
    const bf16* zg = (const bf16*)(ws + WS_ZG) + tokrow * 32 + hd * 3;
    const float gate_c = bf2f(zg[0]), gate_s = bf2f(zg[1]), gate_w = bf2f(zg[2]);
    LAS float* otl = (LAS float*)(lds + 40960 + wave * 8192) + lane;
    unsigned sel;
    {
        const bool two = tile >= 16;
        const bf16* kc = (const bf16*)(ws + WS_KC) + bg * 128 * 64; const bf16* vc = (const bf16*)(ws + WS_VCT) + bg * 64 * 128;
        *(LAS u32x4*)(lds + srow * 144 + sch * 16) = *(const u32x4*)(kc + srow * 64 + sch * 8);
        *(LAS u32x4*)(lds + 18432 + srow * 144 + sch * 16) = *(const u32x4*)(vc + srow * 128 + sch * 8);
        if (two) {
            *(LAS u32x4*)(lds + 9216 + srow * 144 + sch * 16) = *(const u32x4*)(kc + 64 * 64 + srow * 64 + sch * 8);
            *(LAS u32x4*)(lds + 18432 + 9216 + srow * 144 + sch * 16) = *(const u32x4*)(vc + srow * 128 + 64 + sch * 8);
        }
        __syncthreads();
        f32x16 sc[4];
        float lsum = 0.f;
#pragma unroll
        for (int idx = 0; idx < 4; ++idx) {
            const int kt = idx >> 1, kb = idx & 1;
            f32x16 s = zero16();
            if (kt == 0 || two) {
#pragma unroll
                for (int j = 0; j < 4; ++j) s = MFMA32(*(const LAS bf16x8*)(lds + kt * 9216 + (kb * 32 + r) * 144 + (16 * j + 8 * h) * 2), qf[j], s);
                s = MFMA32(aug_k(16 * (kb * 32 + r), h), aug_q(slope_pk, slope2 * (float)(1024 * kt + 31 - tq), h), s);
            }
#pragma unroll
            for (int reg = 0; reg < 16; ++reg) {
                const int n = idx * 32 + crow(reg, h), ce = 16 * n + 31;
                const bool v = (ce <= tq) && (kt == 0 || two);
                const float p = ex2(v ? s[reg] : NEGINF);
                s[reg] = p; lsum += p;
            }
            sc[idx] = s;
        }
        lsum += __shfl_xor(lsum, 32);
        const float inv = (lsum > 0.f) ? 1.f / lsum : 0.f;
        {
            f32x16 o0 = zero16(), o1 = zero16();
#pragma unroll
            for (int idx = 0; idx < 4; ++idx) {
                const int kt = idx >> 1, kb = idx & 1;
                if (kt == 0 || two) {
#pragma unroll
                    for (int s2 = 0; s2 < 2; ++s2) {
                        const bf16x8 pf = pack8(sc[idx], s2);
                        o0 = MFMA32(*(const LAS bf16x8*)(lds + 18432 + kt * 9216 + r * 144 + (kb * 32 + s2 * 16 + 8 * h) * 2), pf, o0);
                        o1 = MFMA32(*(const LAS bf16x8*)(lds + 18432 + kt * 9216 + (32 + r) * 144 + (kb * 32 + s2 * 16 + 8 * h) * 2), pf, o1);
                    }
                }
            }
            const float scl = gate_c * inv;
#pragma unroll
            for (int reg = 0; reg < 16; ++reg) { otl[reg * 64] = scl * o0[reg]; otl[(16 + reg) * 64] = scl * o1[reg]; }
        }
        float own4[16], last[16];
#pragma unroll
        for (int G = 0; G < 16; ++G) {
            const f32x16& sv = sc[G >> 2]; const int b4 = 4 * (G & 3);
            float a = ((sv[b4] + sv[b4 + 1]) + (sv[b4 + 2] + sv[b4 + 3])) * inv, c = sv[b4 + 3] * inv;
            a += dpp_xor1(a); a += dpp_xor2(a); c += dpp_xor1(c); c += dpp_xor2(c);
            own4[G] = a; last[G] = c;
        }
        float impE[16], impO[16];
        {
            float plast[16], impown[16];
#pragma unroll
            for (int G = 0; G < 16; ++G) plast[G] = __shfl_xor(last[G], 32);
#pragma unroll
            for (int G = 0; G < 16; ++G) { const float prev = h ? plast[G] : (G > 0 ? plast[G > 0 ? G - 1 : 0] : 0.f); impown[G] = own4[G] + prev; }
#pragma unroll
            for (int G = 0; G < 16; ++G) { const float oth = __shfl_xor(impown[G], 32); impE[G] = h ? oth : impown[G]; impO[G] = h ? impown[G] : oth; }
        }
        const int cur = tq >> 6;
        sel = 1u | (1u << cur) | (cur > 0 ? (1u << (cur - 1)) : 0u);
        const int nslots = 8 - __popc(sel);
        unsigned key[30];
#pragma unroll
        for (int j = 1; j < 30; ++j) {
            const float v = (j & 1) ? impO[j >> 1] : impE[j >> 1];
            key[j] = (j <= cur - 2) ? ((__float_as_uint(v) & ~31u) | (unsigned)(31 - j)) : 0u;
        }
        unsigned prevk = 0xffffffffu;
#pragma unroll 1
        for (int it = 0; it < 5; ++it) {
            if (it < nslots) {
                unsigned mk = 0u;
#pragma unroll
                for (int j = 1; j < 30; ++j) { const unsigned kk = (key[j] < prevk) ? key[j] : 0u; mk = mk > kk ? mk : kk; }
                if (mk != 0u) sel |= 1u << (31u - (mk & 31u));
                prevk = mk;
            }
        }
        unsigned wm = sel;
#pragma unroll
        for (int o = 1; o < 64; o <<= 1) wm |= (unsigned)__shfl_xor((int)wm, o);
        if (lane == 0) UNI[wave] = wm;
        __syncthreads();
    }
    unsigned uni = 0u;
#pragma unroll
    for (int w = 0; w < 8; ++w) uni |= UNI[w];
    uni = (unsigned)__builtin_amdgcn_readfirstlane((int)uni);
    if (!(dry && PROBE_NSA_MODE == 3)) {
    {
        const int lo = tile > 8 ? tile - 8 : 0;
        const unsigned wl = ((2u << tile) - 1u) & ~((1u << lo) - 1u);
        const size_t slab = (size_t)((1 * 8 + b) * 2 + g);
        nsa_branch<0>(lds, wl, (const bf16*)(ws + WS_KN) + slab * 2048 * 64, (const bf16*)(ws + WS_VT) + slab * 64 * 2048, qf, ka, slope_pk, tile, tq, sel, slope2, gate_w, r, h, tid, otl, dry);
    }
    {
        const size_t slab = (size_t)((0 * 8 + b) * 2 + g);
        nsa_branch<1>(lds, uni, (const bf16*)(ws + WS_KN) + slab * 2048 * 64, (const bf16*)(ws + WS_VT) + slab * 64 * 2048, qf, ka, slope_pk, tile, tq, sel, slope2, gate_s, r, h, tid, otl, dry);
    }
    }
    bf16* yp = (bf16*)(ws + WS_Y) + tokrow * 1024 + hd * 64 + 4 * h;
#pragma unroll
    for (int g4 = 0; g4 < 4; ++g4) {
        u32x2 w0, w1;
        w0.x = pk2(otl[(4 * g4) * 64], otl[(4 * g4 + 1) * 64]); w0.y = pk2(otl[(4 * g4 + 2) * 64], otl[(4 * g4 + 3) * 64]);
        w1.x = pk2(otl[(16 + 4 * g4) * 64], otl[(16 + 4 * g4 + 1) * 64]); w1.y = pk2(otl[(16 + 4 * g4 + 2) * 64], otl[(16 + 4 * g4 + 3) * 64]);
        if (!dry) { *(u32x2*)(yp + 8 * g4) = w0; *(u32x2*)(yp + 32 + 8 * g4) = w1; }
    }
}

DI int next_unit(unsigned* ctr, LAS unsigned char* lds, int tid) {
    volatile LAS int* slot = (volatile LAS int*)(lds + 131072 + 128);
    __syncthreads();
    if (tid == 0) *slot = (int)__hip_atomic_fetch_add(ctr, 1u, __ATOMIC_RELAXED, __HIP_MEMORY_SCOPE_AGENT);
    __syncthreads();
    return *slot;
}
__global__ void __launch_bounds__(512, 2) hybrid_fwd(Args A) {
    extern __shared__ __attribute__((aligned(16))) unsigned char lds_raw[];
    LAS unsigned char* lds = (LAS unsigned char*)lds_raw;
    const int wave = __builtin_amdgcn_readfirstlane((int)(threadIdx.x >> 6));
#define lane xb_lane()
#define tid (wave * 64 + xb_lane())
    const int G = gridDim.x, bid = blockIdx.x;
    unsigned char* ws = A.ws;
    const int lo = A.ph_lo, hi = A.ph_hi;
#ifndef PH_ONLY
#define PH_ONLY -1
#endif
#ifndef PROBE_REP
#define PROBE_REP -1
#endif
#define IN(k) ((PH_ONLY < 0 || PH_ONLY == (k)) && lo <= (k) && (k) < hi)
#define SEAM(k) do { if (IN(k) && IN((k) + 1)) { if (A.coop == 1) xcd_barrier(bar); } } while (0)
    {
        volatile LAS unsigned* st = (volatile LAS unsigned*)(lds + 131072 + 64);
        if (tid < 2) st[tid] = 0u;
        __syncthreads();
    }
    if (A.coop == 2) cg::this_grid().sync();
    XcdBarrier bar; bar.bar = (unsigned*)(ws + WS_BAR); bar.x = 0; bar.st = (volatile LAS unsigned*)(lds + 131072 + 64); bar.wave = wave;
    if (A.coop == 1) bar = xcd_barrier_post((unsigned*)(ws + WS_BAR), (volatile LAS unsigned*)(lds + 131072 + 64), wave);
    if (IN(0)) { phase0(A, lds, tid, lane, wave, 0, bid * 8 + wave, G * 8); __syncthreads(); }
    SEAM(0);
    if (PROBE_REP == 100) { for (int i = 0; i < 10; ++i) xcd_barrier(bar); }
    if (IN(1)) {
        pg8::Gemm g{(const bf16*)(ws + WS_H), (const bf16*)(ws + WS_WIN), M, NINP, DM, wave}; pg8::StaticOrder S; S.init(M, NINP, G, bid);
        EpiZ E{ws};
        if (PROBE_REP == 1) { pg8::gemm_phase<EpiZ, pg8::StaticOrder, true, true>(lds, g, S, E); xcd_barrier(bar); }
        pg8::gemm_phase<EpiZ, pg8::StaticOrder, true, true>(lds, g, S, E);
        { const int nfull = (M / 256) * (NINP / 256) % G;
          if (nfull == 0) phase0(A, lds, tid, lane, wave, 1, bid * 8 + wave, G * 8);
          else if (bid >= nfull) phase0(A, lds, tid, lane, wave, 1, (bid - nfull) * 8 + wave, (G - nfull) * 8);
          __syncthreads(); }
    }
    SEAM(1);
    if (IN(2)) {
        if (PROBE_REP >= 21 && PROBE_REP <= 23) {
            unsigned* ctr0 = (unsigned*)(ws + WS_BAR) + 3664;
            const int nun = PROBE_REP == 21 ? 128 : (PROBE_REP == 22 ? 512 : 256);
            for (;;) {
                const int u = next_unit(ctr0, lds, tid);
                if (u >= nun) break;
                if (PROBE_REP == 21) compress_unit(A, lds, u, tid, lane, wave);
                else if (PROBE_REP == 22) { if (u < 128) rstate_group(A, lds, u, tid, lane, wave); }
                else kvprep_unit(A, lds, u, lane, wave);
            }
            xcd_barrier(bar);
        }
        for (int rep = (PROBE_REP == 2 ? 0 : 1); rep < 2; ++rep) {
        if (PROBE_REP == 2 && rep == 1) xcd_barrier(bar);
        unsigned* ctr = (unsigned*)(ws + WS_BAR) + 3600 + 32 * rep;
        if (G == 256) {
            if (bid < 128) compress_unit(A, lds, bid, tid, lane, wave);
            else rstate_group(A, lds, bid - 128, tid, lane, wave);
            kvprep_unit(A, lds, bid, lane, wave);
        } else
        for (;;) {
            const int u = next_unit(ctr, lds, tid);
            if (u >= 512) break;
            if (u < 128) compress_unit(A, lds, u, tid, lane, wave);
            else if (u < 256) rstate_group(A, lds, u - 128, tid, lane, wave);
            else kvprep_unit(A, lds, u - 256, lane, wave);
        } }
    }
    SEAM(2);
    if (IN(3)) {
#define PH3_NSA(DRY, CTR) do { \
        unsigned* ctr = (unsigned*)(ws + WS_BAR) + (CTR); \
        for (;;) { \
            const int u = next_unit(ctr, lds, tid); \
            if (u >= 512) break; \
            nsa_unit(A, lds, (u & 15) >> 1, u & 1, 31 - (u >> 4), tid, lane, wave, DRY); \
        } } while (0)
#define PH3_ROUT(DRY, CTR) do { \
        unsigned* ctr = (unsigned*)(ws + WS_BAR) + (CTR); \
        for (;;) { \
            const int u = next_unit(ctr, lds, tid); \
            if (u >= 512) break; \
            rout_unit(A, lds, u, tid, lane, wave, DRY); \
        } } while (0)
        if (PROBE_REP == 31) { PH3_NSA(true, 3856); xcd_barrier(bar); }
        if (PROBE_REP == 32) { PH3_ROUT(true, 3888); xcd_barrier(bar); }
        if (G == 256) {
            const int b3 = bid & 7, k3 = bid >> 3;
            nsa_unit(A, lds, b3, k3 & 1, 31 - (k3 >> 1), tid, lane, wave, false); __syncthreads();
            nsa_unit(A, lds, b3, k3 & 1, k3 >> 1, tid, lane, wave, false); __syncthreads();
            rout_unit(A, lds, b3 * 64 + k3 * 2, tid, lane, wave, false);
            rout_unit(A, lds, b3 * 64 + k3 * 2 + 1, tid, lane, wave, false);
        } else {
        PH3_NSA(false, 3792);
        PH3_ROUT(false, 3824);
        }
    }
    SEAM(3);
    if (IN(4)) {
        pg8::Gemm g{(const bf16*)(ws + WS_Y), (const bf16*)(ws + WS_WB), M, DM, DM, wave}; pg8::StaticOrder S; S.init(M, DM, G, bid);
        EpiMix E{(const bf16*)(ws + WS_ZM), (bf16*)(ws + WS_MIX)};
        if (PROBE_REP == 4) { pg8::gemm_phase<EpiMix, pg8::StaticOrder, true, true>(lds, g, S, E); xcd_barrier(bar); }
        pg8::gemm_phase<EpiMix, pg8::StaticOrder, true, true>(lds, g, S, E);
    }
    SEAM(4);
    if (IN(5)) {
        pg8::Gemm g{(const bf16*)(ws + WS_MIX), (const bf16*)(ws + WS_WO), M, DM, DM, wave}; pg8::StaticOrder S; S.init(M, DM, G, bid);
        EpiOut E{A.x, A.out, (bf16*)(ws + WS_X1B), (float*)(ws + WS_SSQ)};
        if (PROBE_REP == 5) { pg8::gemm_phase<EpiOut, pg8::StaticOrder, true, true>(lds, g, S, E); xcd_barrier(bar); }
        pg8::gemm_phase<EpiOut, pg8::StaticOrder, true, true>(lds, g, S, E);
    }
    SEAM(5);
    if (IN(6)) {
        pg8::Gemm g{(const bf16*)(ws + WS_X1B), (const bf16*)(ws + WS_WGU), M, NGU, DM, wave}; pg8::StaticOrder S; S.init(M, NGU, G, bid);
        pg8::Unit u0; u0.pm = -1; u0.pn = 0;
        {
            LAS float* tab = (LAS float*)(lds + 131072 + 1024);
            if (S.next(0, u0) && tid < 256) {
                const f32x4* sp = (const f32x4*)((const float*)(ws + WS_SSQ) + (size_t)(u0.pm * 256 + tid) * 16);
                const f32x4 s0 = sp[0], s1 = sp[1], s2 = sp[2], s3 = sp[3];
                const float tot = ((s0[0] + s0[1]) + (s0[2] + s0[3])) + ((s1[0] + s1[1]) + (s1[2] + s1[3])) + ((s2[0] + s2[1]) + (s2[2] + s2[3])) + ((s3[0] + s3[1]) + (s3[2] + s3[3]));
                tab[tid] = rsqrtf(tot * (1.f / 1024.f) + EPS);
            }
            __syncthreads();
        }
        EpiFfn E{(const LAS float*)(lds + 131072 + 1024), (bf16*)(ws + WS_HID), (const float*)(ws + WS_SSQ), u0.pm};
        if (PROBE_REP == 6) { pg8::gemm_phase<EpiFfn, pg8::StaticOrder, true, true>(lds, g, S, E); xcd_barrier(bar); }
        pg8::gemm_phase<EpiFfn, pg8::StaticOrder, true, true>(lds, g, S, E);
    }
    SEAM(6);
    if (IN(7)) {
        pg8::Gemm g{(const bf16*)(ws + WS_HID), (const bf16*)(ws + WS_WDN), M, DM, DFF, wave}; pg8::StaticOrder S; S.init(M, DM, G, bid);
        if (PROBE_REP == 7) { EpiDown E0{A.out, (const bf16*)(ws + WS_X1B), 1}; pg8::gemm_phase<EpiDown, pg8::StaticOrder, true, true>(lds, g, S, E0); xcd_barrier(bar); }
        EpiDown E{A.out, (const bf16*)(ws + WS_X1B), 0};
        pg8::gemm_phase<EpiDown, pg8::StaticOrder, true, true>(lds, g, S, E);
    }
#undef IN
#undef SEAM
#undef lane
#undef tid
}

extern "C" void kernel_launch(void* const* d_in, const int* in_sizes, int n_in, void* d_out, int out_size, void* d_ws, size_t ws_size, hipStream_t stream) {
    static int grid = 0;
    if (grid == 0) {
        if (n_in != 15 || in_sizes[0] != M * DM || out_size != M * DM || ws_size < WS_END) { fprintf(stderr, "kernel_launch: unexpected shapes (n_in %d, ws %zu)\n", n_in, ws_size); grid = -1; return; }
        int dev = 0, cus = 0, per_cu = 0;
        (void)hipGetDevice(&dev);
        (void)hipDeviceGetAttribute(&cus, hipDeviceAttributeMultiprocessorCount, dev);
        (void)hipFuncSetAttribute((const void*)hybrid_fwd, hipFuncAttributeMaxDynamicSharedMemorySize, LDS_BYTES);
        if (hipOccupancyMaxActiveBlocksPerMultiprocessor(&per_cu, (const void*)hybrid_fwd, 512, LDS_BYTES) != hipSuccess || per_cu < 1) per_cu = 1;
        (void)hipGetLastError();
        grid = cus * per_cu;
#ifdef PROBE_GRID
        grid = PROBE_GRID;
#endif
        if (grid < 1) grid = 256;
    }
    if (grid < 0) return;
    Args a{};
    a.x = (const float*)d_in[0]; a.n1g = (const float*)d_in[1]; a.win = (const float*)d_in[2]; a.qg = (const float*)d_in[3]; a.kg = (const float*)d_in[4];
    a.pe = (const float*)d_in[5]; a.w1 = (const float*)d_in[6]; a.w2 = (const float*)d_in[7]; a.gng = (const float*)d_in[8]; a.wb = (const float*)d_in[9];
    a.wo = (const float*)d_in[10]; a.n2g = (const float*)d_in[11]; a.wg = (const float*)d_in[12]; a.wu = (const float*)d_in[13]; a.wd = (const float*)d_in[14];
    a.out = (float*)d_out; a.ws = (unsigned char*)d_ws;
#if MK_SPLIT
    for (int p = 0; p < 8; ++p) {
        a.ph_lo = p; a.ph_hi = p + 1; a.coop = 0;
        hipLaunchKernelGGL(hybrid_fwd, dim3(grid), dim3(512), LDS_BYTES, stream, a);
    }
#else
    a.ph_lo = 0; a.ph_hi = 8; a.coop = 1;
    (void)hipMemsetAsync((unsigned char*)d_ws + WS_BAR, 0, BAR_BYTES, stream);
    void* args[] = {&a};
    hipError_t e = hipLaunchCooperativeKernel((const void*)hybrid_fwd, dim3(grid), dim3(512), args, LDS_BYTES, stream);
    if (e != hipSuccess) fprintf(stderr, "cooperative launch failed: %s (grid %d)\n", hipGetErrorString(e), grid);
#ifdef PROBE_TWICE
    (void)hipMemsetAsync((unsigned char*)d_ws + WS_BAR, 0, BAR_BYTES, stream);
    (void)hipLaunchCooperativeKernel((const void*)hybrid_fwd, dim3(grid), dim3(512), args, LDS_BYTES, stream);
#endif
#endif
}
```
